# Optimizing an MI355X kernel written in HIP

```python
import math
import jax, jax.numpy as jnp
from jax import lax
import numpy as np

D_MODEL = 2048
BATCH = 4
SEQ = 4096
DEPTH = 4

GRID_W = 64
CTX_LEN = 256
N_MIXERS = 2
N_DN_LAYERS = (DEPTH + 1) // 2
N_FN_LAYERS = DEPTH // 2
DN_HEADS = 16
DN_HEAD_DIM = D_MODEL // DN_HEADS
DN_WIDTH = DN_HEADS * DN_HEAD_DIM
DN_IN = 4 * DN_WIDTH + 4 * DN_HEADS
CONV_W = 5
CHUNK = 64
FN_GROUPS = 4
FN_WIDTH = D_MODEL
FN_GROUP_DIM = FN_WIDTH // FN_GROUPS
N_EXPERTS = 16
N_GROUPS = 4
EXPERTS_PER_GROUP = N_EXPERTS // N_GROUPS
GROUP_SCORE_K = 2
TOP_K = 2
D_FF = 512
N_MOD = 6
EPS = 1e-6

kernel_name = "hybrid_deltanet_fnet_grouped_moe_dit"


def _rmsnorm(x, w):
    x32 = x.astype(jnp.float32)
    y = x32 * lax.rsqrt(jnp.mean(x32 * x32, axis=-1, keepdims=True) + EPS)
    return (y * w.astype(jnp.float32)).astype(x.dtype)


def _modulate(x, w, shift, scale):
    return _rmsnorm(x, w) * (1 + scale) + shift


def _l2norm(x):
    return x * lax.rsqrt(jnp.sum(x * x, axis=-1, keepdims=True) + EPS)


def _dwconv_centred(u, w):
    L = u.shape[-2]
    pad = CONV_W // 2
    up = jnp.pad(u, [(0, 0)] * (u.ndim - 2) + [(pad, pad), (0, 0)])
    return sum(up[..., j:j + L, :] * w[j] for j in range(CONV_W))


def _gated_delta(q, k, v, log_alpha, beta, s0):
    B, T, H, dk = q.shape
    dv = v.shape[-1]
    n = T // CHUNK

    def chunks(t):
        t = t.reshape((B, n, CHUNK, H) + t.shape[3:])
        return jnp.moveaxis(t, 3, 1)

    q, k, v, beta = chunks(q), chunks(k), chunks(v), chunks(beta)
    g = jnp.cumsum(chunks(log_alpha), axis=-1)
    causal = jnp.tril(jnp.ones((CHUNK, CHUNK), bool))
    strict = jnp.tril(jnp.ones((CHUNK, CHUNK), bool), -1)
    decay = jnp.exp(jnp.where(causal, g[..., :, None] - g[..., None, :], -jnp.inf))
    kb = k * beta[..., None]
    lower = jnp.where(strict, jnp.einsum("bhncd,bhnsd->bhncs", kb, k) * decay, 0.0)
    eye = jnp.eye(CHUNK, dtype=q.dtype)
    t_mat = lax.linalg.triangular_solve(eye + lower, jnp.broadcast_to(eye, lower.shape),
                                        left_side=True, lower=True)
    u = jnp.einsum("bhncs,bhnsv->bhncv", t_mat, v * beta[..., None])
    w = jnp.einsum("bhncs,bhnsk->bhnck", t_mat, kb * jnp.exp(g)[..., None])
    intra = jnp.einsum("bhncd,bhnsd->bhncs", q, k) * decay
    q_g = q * jnp.exp(g)[..., None]
    k_g = k * jnp.exp(g[..., -1:] - g)[..., None]
    g_last = jnp.exp(g[..., -1])

    def step(s, xs):
        u_c, w_c, a_c, qg_c, kg_c, gl_c = xs
        v_new = u_c - jnp.einsum("bhck,bhkv->bhcv", w_c, s)
        o_c = jnp.einsum("bhck,bhkv->bhcv", qg_c, s) + jnp.einsum("bhcs,bhsv->bhcv", a_c, v_new)
        s = s * gl_c[..., None, None] + jnp.einsum("bhck,bhcv->bhkv", kg_c, v_new)
        return s, o_c

    xs = tuple(jnp.moveaxis(t, 2, 0) for t in (u, w, intra, q_g, k_g, g_last))
    s_final, o = lax.scan(step, s0, xs)
    o = jnp.transpose(o, (1, 0, 3, 2, 4)).reshape(B, T, H, dv)
    return o, s_final


def _dn_streams(p, conv_w, A_log, dt_bias, on_grid):
    B, T, _ = p.shape
    qkv = p[..., :3 * DN_WIDTH]
    if on_grid:
        rows = T // GRID_W
        qkv = _dwconv_centred(qkv.reshape(B, rows, GRID_W, 3 * DN_WIDTH), conv_w)
        qkv = qkv.reshape(B, T, 3 * DN_WIDTH)
    else:
        qkv = _dwconv_centred(qkv, conv_w)
    qkv = jax.nn.silu(qkv).astype(jnp.float32).reshape(B, T, 3, DN_HEADS, DN_HEAD_DIM)
    q = _l2norm(qkv[:, :, 0]) * (DN_HEAD_DIM ** -0.5)
    k = _l2norm(qkv[:, :, 1])
    v = qkv[:, :, 2]
    gate = p[..., 3 * DN_WIDTH:4 * DN_WIDTH]
    a = p[..., 4 * DN_WIDTH:4 * DN_WIDTH + 2 * DN_HEADS].astype(jnp.float32).reshape(B, T, 2, DN_HEADS)
    b = p[..., 4 * DN_WIDTH + 2 * DN_HEADS:].astype(jnp.float32).reshape(B, T, 2, DN_HEADS)
    log_alpha = -jnp.exp(A_log.astype(jnp.float32)) * jax.nn.softplus(a + dt_bias.astype(jnp.float32))
    beta = jax.nn.sigmoid(b)
    return q, k, v, log_alpha, beta, gate


def _directional_scan(streams, d, s0):
    q, k, v, log_alpha, beta, _ = streams
    la, bt = log_alpha[:, :, d], beta[:, :, d]
    if d == 1:
        q, k, v, la, bt = (jnp.flip(t, axis=1) for t in (q, k, v, la, bt))
    o, s = _gated_delta(q, k, v, la, bt, s0)
    if d == 1:
        o = jnp.flip(o, axis=1)
    return o, s


def _dn_output(o, gate, norm_w, w_out):
    B, T = o.shape[:2]
    g = jax.nn.silu(gate.astype(jnp.float32)).reshape(B, T, DN_HEADS, DN_HEAD_DIM)
    y = (_rmsnorm(o, norm_w) * g).reshape(B, T, DN_WIDTH).astype(gate.dtype)
    return y @ w_out


def _deltanet_mixer(h_ctx, h_lat, w_in, conv_w, A_log, dt_bias, norm_w, w_out, ctx_out):
    B = h_lat.shape[0]
    ctx_s = _dn_streams(h_ctx @ w_in, conv_w, A_log, dt_bias, on_grid=False)
    lat_s = _dn_streams(h_lat @ w_in, conv_w, A_log, dt_bias, on_grid=True)
    o_ctx, o_lat = 0.0, 0.0
    for d in range(2):
        s0 = jnp.zeros((B, DN_HEADS, DN_HEAD_DIM, DN_HEAD_DIM), jnp.float32)
        oc, s_ctx = _directional_scan(ctx_s, d, s0)
        ol, _ = _directional_scan(lat_s, d, s_ctx)
        o_lat = o_lat + ol
        if ctx_out:
            o_ctx = o_ctx + oc
    y_lat = _dn_output(o_lat, lat_s[5], norm_w, w_out)
    y_ctx = _dn_output(o_ctx, ctx_s[5], norm_w, w_out) if ctx_out else None
    return y_ctx, y_lat


def _fourier_mixer(h, w_in, w_out):
    u = h @ w_in
    B, T, _ = u.shape
    u = u.astype(jnp.float32).reshape(B, T, FN_GROUPS, FN_GROUP_DIM)
    mixed = jnp.fft.fft2(u, axes=(1, 3), norm="ortho").real
    return mixed.reshape(B, T, FN_WIDTH).astype(h.dtype) @ w_out


def _moe(h, router_w, router_bias, w_gate, w_up, w_down):
    s = jax.nn.sigmoid(h.astype(jnp.float32) @ router_w.astype(jnp.float32))
    sel = (s + router_bias.astype(jnp.float32)).reshape(s.shape[:-1] + (N_GROUPS, EXPERTS_PER_GROUP))
    group_score = jnp.sum(lax.top_k(sel, GROUP_SCORE_K)[0], axis=-1)
    g_idx = jnp.argmax(group_score, axis=-1)
    in_group = jnp.arange(N_GROUPS) == g_idx[..., None]
    masked = jnp.where(in_group[..., None], sel, -jnp.inf).reshape(s.shape)
    _, e_idx = lax.top_k(masked, TOP_K)
    wts = jnp.take_along_axis(s, e_idx, axis=-1)
    wts = wts / jnp.sum(wts, axis=-1, keepdims=True)
    combine = jnp.sum(jax.nn.one_hot(e_idx, N_EXPERTS, dtype=jnp.float32) * wts[..., None],
                      axis=-2).astype(h.dtype)
    y = jnp.zeros_like(h)
    for e in range(N_EXPERTS):
        act = jax.nn.silu(h @ w_gate[e]) * (h @ w_up[e])
        y = y + combine[..., e:e + 1] * (act @ w_down[e])
    return y


def setup_inputs(seed: int = 0) -> dict:
    key = jax.random.key(seed)
    ks = jax.random.split(key, 22)
    f32 = jnp.float32

    def nrm(k, shape, scale):
        return jax.random.normal(k, shape, f32) * scale

    dt = jnp.exp(jax.random.uniform(ks[11], (N_DN_LAYERS, 2, DN_HEADS), f32,
                                    math.log(1e-3), math.log(1e-1)))
    return {
        "x": nrm(ks[0], (BATCH, SEQ, D_MODEL), 1.0),
        "c": nrm(ks[1], (BATCH, D_MODEL), 1.0),
        "ctx": nrm(ks[2], (BATCH, CTX_LEN, D_MODEL), 1.0),
        "c_ctx": nrm(ks[3], (D_MODEL,), 1.0),
        "ada_w": nrm(ks[4], (DEPTH, D_MODEL, N_MOD * D_MODEL), 0.5 * D_MODEL ** -0.5),
        "ada_b": nrm(ks[5], (DEPTH, N_MOD * D_MODEL), 0.02),
        "norm_mix_w": 1.0 + nrm(ks[6], (DEPTH, D_MODEL), 0.02),
        "norm_ffn_w": 1.0 + nrm(ks[7], (DEPTH, D_MODEL), 0.02),
        "dn_w_in": nrm(ks[8], (N_DN_LAYERS, D_MODEL, DN_IN), D_MODEL ** -0.5),
        "dn_conv_w": nrm(ks[9], (N_DN_LAYERS, CONV_W, 3 * DN_WIDTH), CONV_W ** -0.5),
        "dn_A_log": jnp.log(jax.random.uniform(ks[10], (N_DN_LAYERS, 2, DN_HEADS), f32, 1.0, 16.0)),
        "dn_dt_bias": dt + jnp.log(-jnp.expm1(-dt)),
        "dn_norm_w": 1.0 + nrm(ks[12], (N_DN_LAYERS, DN_HEAD_DIM), 0.02),
        "dn_w_out": nrm(ks[13], (N_DN_LAYERS, DN_WIDTH, D_MODEL), DN_WIDTH ** -0.5),
        "fn_w_in": nrm(ks[14], (N_FN_LAYERS, D_MODEL, FN_WIDTH), D_MODEL ** -0.5),
        "fn_w_out": nrm(ks[15], (N_FN_LAYERS, FN_WIDTH, D_MODEL), FN_WIDTH ** -0.5),
        "router_w": nrm(ks[16], (D_MODEL, N_EXPERTS), D_MODEL ** -0.5),
        "router_bias": nrm(ks[17], (N_EXPERTS,), 0.01),
        "moe_w_gate": nrm(ks[18], (DEPTH, N_EXPERTS, D_MODEL, D_FF), D_MODEL ** -0.5),
        "moe_w_up": nrm(ks[19], (DEPTH, N_EXPERTS, D_MODEL, D_FF), D_MODEL ** -0.5),
        "moe_w_down": nrm(ks[20], (DEPTH, N_EXPERTS, D_FF, D_MODEL), D_FF ** -0.5),
        "final_norm_w": 1.0 + nrm(ks[21], (D_MODEL,), 0.02),
    }


def reference(x, c, ctx, c_ctx, ada_w, ada_b, norm_mix_w, norm_ffn_w, dn_w_in, dn_conv_w,
              dn_A_log, dn_dt_bias, dn_norm_w, dn_w_out, fn_w_in, fn_w_out, router_w,
              router_bias, moe_w_gate, moe_w_up, moe_w_down, final_norm_w):
    z = ctx
    silu_c = jax.nn.silu(c)
    silu_cc = jax.nn.silu(c_ctx)
    for i in range(DEPTH):
        use_dn = i % N_MIXERS == 0
        j = i // N_MIXERS
        ctx_out = i < DEPTH - 1
        ctx_live = use_dn or ctx_out
        mod = (silu_c @ ada_w[i] + ada_b[i])[:, None, :]
        sh_m, sc_m, g_m, sh_f, sc_f, g_f = jnp.split(mod, N_MOD, axis=-1)
        if ctx_live:
            mod_c = silu_cc @ ada_w[i] + ada_b[i]
            ch_m, cs_m, cg_m, ch_f, cs_f, cg_f = jnp.split(mod_c, N_MOD, axis=-1)

        h_lat = _modulate(x, norm_mix_w[i], sh_m, sc_m)
        if use_dn:
            h_ctx = _modulate(z, norm_mix_w[i], ch_m, cs_m)
            y_ctx, y_lat = _deltanet_mixer(h_ctx, h_lat, dn_w_in[j], dn_conv_w[j], dn_A_log[j],
                                           dn_dt_bias[j], dn_norm_w[j], dn_w_out[j], ctx_out)
        else:
            y_lat = _fourier_mixer(h_lat, fn_w_in[j], fn_w_out[j])
            y_ctx = (_fourier_mixer(_modulate(z, norm_mix_w[i], ch_m, cs_m), fn_w_in[j], fn_w_out[j])
                     if ctx_out else None)
        x = x + g_m * y_lat

        h_lat = _modulate(x, norm_ffn_w[i], sh_f, sc_f)
        x = x + g_f * _moe(h_lat, router_w, router_bias, moe_w_gate[i], moe_w_up[i], moe_w_down[i])
        if ctx_out:
            z = z + cg_m * y_ctx
            h_ctx = _modulate(z, norm_ffn_w[i], ch_f, cs_f)
            z = z + cg_f * _moe(h_ctx, router_w, router_bias, moe_w_gate[i], moe_w_up[i], moe_w_down[i])
    return _rmsnorm(x, final_norm_w)
```

```cpp
#include <hip/hip_runtime.h>
#include <cstdio>
#include <cstdint>

#ifndef N_LAUNCH_MODE
#define N_LAUNCH_MODE 0
#endif

#define F8G1 1
#define F8G2 1
#define F8G2F 1
#define F8FN 1
#define F8QK 1
#define F8O 1
#define F8YE 1
#define LAS __attribute__((address_space(3)))
typedef unsigned short bf16_t;
typedef short bf16x8 __attribute__((ext_vector_type(8)));
typedef float f32x4 __attribute__((ext_vector_type(4)));
typedef float f32x2 __attribute__((ext_vector_type(2)));
typedef unsigned u32x4 __attribute__((ext_vector_type(4)));
typedef unsigned u32x2 __attribute__((ext_vector_type(2)));
#define DI __device__ __forceinline__

constexpr int D = 2048, NB = 4, SEQ = 4096, CTXL = 256, DEPTH = 4;
constexpr int NLAT = NB * SEQ, NCTX = NB * CTXL, NR = NLAT + NCTX;
constexpr int HEADS = 16, HD = 128, DN_IN = 8256, DN_INP = 8448;
constexpr int NEXP = 16, DFF = 512, NMOD = 6;
constexpr int NCH = 68;
constexpr int NUNIT = NB * HEADS * NCH;
constexpr int SLOT_ROWS = 39168;
constexpr int LIST_CAP = NR;
constexpr float EPS = 1e-6f;
constexpr int NT = 512, NW = 8;

constexpr size_t AL(size_t x) { return (x + 255) & ~(size_t)255; }
constexpr size_t WS_CTL = 0;
constexpr size_t CTL_BYTES = 65536;
constexpr size_t WS_MOD = WS_CTL + CTL_BYTES;
constexpr size_t WS_DT = AL(WS_MOD + (size_t)DEPTH * 5 * NMOD * D * 4);
constexpr size_t WS_CT = AL(WS_DT + (size_t)1024 * 512 * 2);
constexpr size_t WS_CT2 = AL(WS_CT + (size_t)4096 * 8192 * 2);
constexpr size_t WS_RWP = AL(WS_CT2 + (size_t)256 * 512 * 2);
constexpr size_t WS_XS = AL(WS_RWP + (size_t)D * NEXP * 4);
constexpr size_t WS_HB = AL(WS_XS + (size_t)NR * D * 2);
constexpr size_t WS_WMIX = AL(WS_HB + (size_t)NR * D * 2);
constexpr size_t WMIX_BYTES = (size_t)DN_INP * D * 2 + (size_t)D * D * 2;
constexpr size_t WS_WGU = AL(WS_WMIX + WMIX_BYTES);
constexpr size_t WS_WD = AL(WS_WGU + (size_t)NEXP * 1024 * D * 2);
constexpr size_t WS_WB2 = AL(WS_WD + (size_t)NEXP * D * DFF * 2);
constexpr size_t WS_WP2 = AL(WS_WB2 + (size_t)2 * D * D * 2);
constexpr size_t WS_ROUTE = AL(WS_WP2 + (size_t)2 * D * D * 2);
constexpr size_t WS_LIST = AL(WS_ROUTE + (size_t)NR * 32);
constexpr size_t WS_ACT = AL(WS_LIST + (size_t)NEXP * LIST_CAP * 4);
constexpr size_t WS_YE = AL(WS_ACT + (size_t)SLOT_ROWS * DFF * 2);
constexpr size_t WS_SCR = AL(WS_YE + (size_t)SLOT_ROWS * D * 2);
constexpr size_t SC_P = WS_SCR;
constexpr size_t SC_AB = AL(SC_P + (size_t)NR * 8192 * 2);
constexpr size_t SC_QN = AL(SC_AB + (size_t)NR * 64 * 4);
constexpr size_t SC_KT = AL(SC_QN + (size_t)NUNIT * 64 * 128 * 2);
constexpr size_t SC_UT = AL(SC_KT + (size_t)NUNIT * 64 * 128 * 2);
constexpr size_t SC_W = AL(SC_UT + (size_t)2 * NUNIT * 64 * 128 * 2);
constexpr size_t SC_AI = AL(SC_W + (size_t)2 * NUNIT * 64 * 128 * 2);
constexpr size_t SC_G = AL(SC_AI + (size_t)2 * NUNIT * 64 * 64 * 2);
constexpr size_t SC_O = AL(SC_G + (size_t)2 * NUNIT * 64 * 4);
constexpr size_t SC_DN_END = AL(SC_O + (size_t)2 * NR * D * 2);
constexpr size_t SC_YT = WS_SCR;
constexpr size_t SC_YTC = AL(SC_YT + (size_t)NB * D * 4096 * 2);
constexpr size_t SC_YN = AL(SC_YTC + (size_t)NB * D * 256 * 2);
constexpr size_t SC_YNC = AL(SC_YN + (size_t)16 * 4096 * 2);
constexpr size_t SC_FN_END = AL(SC_YNC + (size_t)16 * 256 * 2);
constexpr size_t WS_END = SC_DN_END > SC_FN_END ? SC_DN_END : SC_FN_END;
static_assert(WS_END <= (size_t)1600 * 1000 * 1000, "workspace map too large");
constexpr size_t WM_IN = WS_WMIX;
constexpr size_t WM_OUT = WS_WMIX + (size_t)DN_INP * D * 2;
constexpr int CW_BAR = 0;
constexpr int CW_DNQ = 8192;
constexpr int CW_CNT = 4096;
#define XB_TMO      128
#define XB_XCNT(j)  (256  + 64 * (j))
#define XB_XSUB(j)  (1280 + 64 * (j))
#define XB_XGEN(j)  (2304 + 64 * (j))
#define XB_TOP      3328
#define XB_TOPGEN   3392
#define XCD_BAR_WORDS 3456
#define XB_SPIN_CAP (1u << 18)

__device__ __forceinline__ unsigned xb_ld(unsigned* p)              { return __hip_atomic_load(p, __ATOMIC_RELAXED, __HIP_MEMORY_SCOPE_AGENT); }
__device__ __forceinline__ unsigned xb_add(unsigned* p, unsigned v) { return __hip_atomic_fetch_add(p, v, __ATOMIC_RELAXED, __HIP_MEMORY_SCOPE_AGENT); }
__device__ __forceinline__ unsigned xb_xcc_id() { return (unsigned)__builtin_amdgcn_s_getreg((3 << 11) | 20) & 0xFu; }
#define XB_SPIN(cond, bar) do { unsigned _sp = 0; while (cond) { __builtin_amdgcn_s_sleep(1); \
    if ((++_sp & 255u) == 0u) { if (xb_ld(&(bar)[XB_TMO])) break; if (_sp > XB_SPIN_CAP) { atomicAdd(&(bar)[XB_TMO], 1u); break; } } } } while (0)

struct XcdBarrier {
    unsigned* bar; unsigned x;
    volatile LAS unsigned* st;
};

__device__ __forceinline__ XcdBarrier xcd_barrier_post(unsigned* bar, volatile LAS unsigned* st) {
    XcdBarrier b; b.bar = bar; b.x = xb_xcc_id(); b.st = st;
    if (threadIdx.x == 0) (void)xb_add(&bar[XB_XCNT(b.x)], 1u);
    return b;
}
__device__ __forceinline__ void xcd_barrier_complete(unsigned* bar, unsigned x, unsigned& nloc, unsigned& nx) {
    const unsigned G = gridDim.x * gridDim.y * gridDim.z;
    unsigned sum, cnt, mine, sp = 0u;
    for (;;) {
        sum = 0u; cnt = 0u; mine = 0u;
#pragma unroll
        for (unsigned j = 0; j < 16; ++j) { const unsigned c = xb_ld(&bar[XB_XCNT(j)]); sum += c; cnt += (c > 0u) ? 1u : 0u; mine = (j == x) ? c : mine; }
        if (sum == G) break;
        __builtin_amdgcn_s_sleep(1);
        if ((++sp & 255u) == 0u) { if (xb_ld(&bar[XB_TMO])) break; if (sp > XB_SPIN_CAP) { atomicAdd(&bar[XB_TMO], 1u); break; } }
    }
    nloc = mine > 0u ? mine : 1u; nx = cnt > 0u ? cnt : 1u;
}

__device__ __forceinline__ void xcd_barrier(const XcdBarrier& b) {
    asm volatile("s_waitcnt vmcnt(0)" ::: "memory");
    __syncthreads();
    if (threadIdx.x == 0) {
        unsigned* bar = b.bar;
        __builtin_amdgcn_s_waitcnt(0);
        unsigned nloc = b.st[0], nx = b.st[1];
        if (nloc == 0u) { xcd_barrier_complete(bar, b.x, nloc, nx); b.st[0] = nloc; b.st[1] = nx; }
        const unsigned old = xb_add(&bar[XB_XSUB(b.x)], 1u);
        const unsigned gen = old / nloc;
        if (old + 1u == (gen + 1u) * nloc) {
            __builtin_amdgcn_fence(__ATOMIC_RELEASE, "agent");
            asm volatile("s_waitcnt vmcnt(0)" ::: "memory");
            const unsigned og = xb_add(&bar[XB_TOP], 1u);
            const unsigned tg = og / nx;
            if (og + 1u == (tg + 1u) * nx) xb_add(&bar[XB_TOPGEN], 1u);
            else XB_SPIN(xb_ld(&bar[XB_TOPGEN]) == tg, bar);
            __builtin_amdgcn_fence(__ATOMIC_ACQUIRE, "agent");
            xb_add(&bar[XB_XGEN(b.x)], 1u);
            asm volatile("s_waitcnt vmcnt(0)" ::: "memory");
        } else {
            XB_SPIN(xb_ld(&bar[XB_XGEN(b.x)]) == gen, bar);
            __builtin_amdgcn_fence(__ATOMIC_ACQUIRE, "agent");
            asm volatile("s_waitcnt vmcnt(0)" ::: "memory");
        }
    }
    __syncthreads();
}

namespace pg8 {
constexpr int BM = 256, BK = 64, HALF = 128, HTB = HALF * BK * 2  , STAGE_BYTES = 8 * HTB;
__host__ __device__ __forceinline__ int lds_byte(int r, int c) { const int st = (r >> 4) * 2 + (c >> 5), rr = r & 15, cc = c & 31, ob = rr * 64 + cc * 2; return st * 1024 + (ob ^ (((ob >> 9) & 1) << 5)); }
__host__ __device__ __forceinline__ void stage_rc(int b, int& R, int& C) { const int st = b / 1024, sb = b % 1024, swz = sb ^ (((sb >> 9) & 1) << 5); R = (st >> 1) * 16 + swz / 64; C = (st & 1) * 32 + (swz % 64) / 2; }
__host__ __device__ __forceinline__ int perm32(int rho) { const int n = rho >> 4, i = rho & 15; return 8 * (i >> 2) + 4 * n + (i & 3); }

struct Unit { const char* A; const char* B; int pm, pn, aux, aux2; };

typedef __bf16 hbf16x2_ __attribute__((ext_vector_type(2)));
DI unsigned cvt_pk_bf16(float lo, float hi) { const f32x2 v = {lo, hi}; return __builtin_bit_cast(unsigned, __builtin_convertvector(v, hbf16x2_)); }

typedef int i32x8_ __attribute__((ext_vector_type(8)));
typedef int i32x4_ __attribute__((ext_vector_type(4)));
DI i32x8_ cat8(const bf16x8& a, const bf16x8& b) { const i32x4_ x = __builtin_bit_cast(i32x4_, a), y = __builtin_bit_cast(i32x4_, b); return __builtin_shufflevector(x, y, 0, 1, 2, 3, 4, 5, 6, 7); }
DI const char* uni_ptr(const char* p) { const unsigned long long v = (unsigned long long)p; const unsigned lo = __builtin_amdgcn_readfirstlane((unsigned)v), hi = __builtin_amdgcn_readfirstlane((unsigned)(v >> 32));
    const char* q = (const char*)(((unsigned long long)hi << 32) | lo); asm volatile("" : "+s"(q)); return q; }
template <class Epi, class Sched, bool GATHER, int FP8 = 0>
__device__ __forceinline__ void gemm_phase(LAS unsigned char* lds, const int tid, const int K, const int lda, const int ldb, const Sched& S, const Epi& E) {
    const int wid = __builtin_amdgcn_readfirstlane(tid >> 6), lane = tid & 63, wr = wid >> 2, wc = wid & 3, fr = lane & 15, fq = lane >> 4;
    const int nt = K / BK;
    unsigned voffA[2], voffB[2]; int rA[2], cA2[2];
#pragma unroll
    for (int i = 0; i < 2; ++i) { int R, C; stage_rc(tid * 16 + i * 8192, R, C); const int Rb = Epi::PERM ? ((R & ~31) + perm32(R & 31)) : R;
        voffA[i] = (unsigned)(R * lda + C) * 2u; voffB[i] = (unsigned)(Rb * ldb + C) * 2u; rA[i] = R; cA2[i] = C * 2; }
    const size_t kstep = (size_t)(BK * 2);
    const size_t hstepA = (size_t)HALF * lda * 2, hstepB = (size_t)HALF * ldb * 2, pstepA = (size_t)64 * lda * 2, pstepB = (size_t)64 * ldb * 2;
    const unsigned ldsw = (unsigned)wid * 1024u;
    const int aoff = lds_byte(wr * 64 + fr, fq * 8), boff = lds_byte(wc * 32 + fr, fq * 8);
#define PG8_SA(b, h) (((b) * 2 + (h)) * HTB)
#define PG8_SB(b, h) ((4 + (b) * 2 + (h)) * HTB)
#define PG8_STAGE(bufoff, gbase, voff) do { _Pragma("unroll") for (int _i = 0; _i < 2; ++_i) { const char* _p = uni_ptr((const char*)(gbase) + (size_t)_i * pstepB); unsigned _o = (voff)[0]; asm volatile("" : "+v"(_o)); \
        __builtin_amdgcn_global_load_lds((const unsigned*)(_p + _o), (LAS unsigned*)(lds + (bufoff) + ldsw + _i * 8192), 16, 0, 0); } } while (0)
#define PG8_STAGE_A(bufoff, gbase, h, usenext) do { _Pragma("unroll") for (int _i = 0; _i < 2; ++_i) { \
        const char* _p = uni_ptr((const char*)(gbase) + (GATHER ? (size_t)0 : (size_t)(h) * hstepA + (size_t)_i * pstepA)); \
        unsigned _o = GATHER ? ((usenext) ? gn[h][_i] : gc[h][_i]) : voffA[0]; asm volatile("" : "+v"(_o)); \
        __builtin_amdgcn_global_load_lds((const unsigned*)(_p + _o), (LAS unsigned*)(lds + (bufoff) + ldsw + _i * 8192), 16, 0, 0); } } while (0)
#define PG8_LDA(dst, b, h) do { _Pragma("unroll") for (int m = 0; m < 4; ++m) _Pragma("unroll") for (int k = 0; k < 2; ++k) dst[m][k] = *(const LAS bf16x8*)(lds + PG8_SA(b, h) + aoff + m * 2048 + k * 1024); } while (0)
#define PG8_LDB(dst, b, h) do { _Pragma("unroll") for (int n = 0; n < 2; ++n) _Pragma("unroll") for (int k = 0; k < 2; ++k) dst[n][k] = *(const LAS bf16x8*)(lds + PG8_SB(b, h) + boff + n * 2048 + k * 1024); } while (0)
#define PG8_MMA(ai, bj, At, Bt) do { __builtin_amdgcn_s_setprio(1); \
        if constexpr (FP8 != 0) { _Pragma("unroll") for (int m = 0; m < 4; ++m) _Pragma("unroll") for (int n = 0; n < 2; ++n) \
            acc[ai][bj][m][n] = __builtin_amdgcn_mfma_scale_f32_16x16x128_f8f6f4(cat8(Bt[n][0], Bt[n][1]), cat8(At[m][0], At[m][1]), acc[ai][bj][m][n], 0, 0, 0, FP8, 0, 0x7f); } \
        else { _Pragma("unroll") for (int m = 0; m < 4; ++m) _Pragma("unroll") for (int n = 0; n < 2; ++n) _Pragma("unroll") for (int k = 0; k < 2; ++k) \
            acc[ai][bj][m][n] = __builtin_amdgcn_mfma_f32_16x16x32_bf16(Bt[n][k], At[m][k], acc[ai][bj][m][n], 0, 0, 0); } \
        __builtin_amdgcn_s_setprio(0); } while (0)
#define PG8_WAIT_V(n) asm volatile("s_waitcnt vmcnt(" #n ")" ::: "memory")
#define PG8_WAIT_L(n) asm volatile("s_waitcnt lgkmcnt(" #n ")" ::: "memory")
#define PG8_BAR __builtin_amdgcn_s_barrier()
#define PG8_SCHED __builtin_amdgcn_sched_barrier(0)
    Unit cur, nxt; int ui = 0;
    if (!S.next(0, cur)) return;
    unsigned gc[2][2], gn[2][2];
    if constexpr (GATHER) {
#pragma unroll
        for (int h = 0; h < 2; ++h)
#pragma unroll
            for (int i = 0; i < 2; ++i) { gc[h][i] = (unsigned)S.grow(cur, h * HALF + rA[i]) * (unsigned)(lda * 2) + (unsigned)cA2[i]; gn[h][i] = gc[h][i]; }
    } else { gc[0][0] = gc[0][1] = gc[1][0] = gc[1][1] = 0u; gn[0][0] = gn[0][1] = gn[1][0] = gn[1][1] = 0u; }
    f32x4 acc[2][2][4][2];
#pragma unroll
    for (int a = 0; a < 2; ++a)
#pragma unroll
        for (int b = 0; b < 2; ++b)
#pragma unroll
            for (int m = 0; m < 4; ++m)
#pragma unroll
                for (int n = 0; n < 2; ++n) acc[a][b][m][n] = (f32x4){0.f, 0.f, 0.f, 0.f};
    bf16x8 At[4][2], B0[2][2], B1[2][2];
    const char* cA = cur.A; const char* cB = cur.B;
    PG8_STAGE(PG8_SB(0, 0), cB, voffB); PG8_STAGE(PG8_SB(0, 1), cB + hstepB, voffB); PG8_STAGE_A(PG8_SA(0, 0), cA, 0, false); PG8_STAGE_A(PG8_SA(0, 1), cA, 1, false);
    if (wr == 1) PG8_BAR;
    PG8_WAIT_V(2); PG8_BAR;
    PG8_STAGE(PG8_SB(1, 0), cB + kstep, voffB); PG8_STAGE_A(PG8_SA(1, 0), cA + kstep, 0, false); PG8_STAGE(PG8_SB(1, 1), cB + hstepB + kstep, voffB);
    PG8_WAIT_V(6); PG8_BAR;
    for (;;) {
        const bool has_next = S.next(ui + 1, nxt);
        const char* nA = has_next ? nxt.A : cA; const char* nB = has_next ? nxt.B : cB;
        if constexpr (GATHER) { if (has_next) {
#pragma unroll
            for (int h = 0; h < 2; ++h)
#pragma unroll
                for (int i = 0; i < 2; ++i) gn[h][i] = (unsigned)S.grow(nxt, h * HALF + rA[i]) * (unsigned)(lda * 2) + (unsigned)cA2[i]; } }
        for (int t = 0; t < nt; t += 2) {
            const bool last = (t == nt - 2);
            const char* a1 = cA + (size_t)(t + 1) * kstep;
            const char* a2 = last ? nA : cA + (size_t)(t + 2) * kstep; const char* b2 = last ? nB : cB + (size_t)(t + 2) * kstep;
            const char* a3 = a2 + kstep; const char* b3 = b2 + kstep;
            PG8_LDB(B0, 0, 0); PG8_LDB(B1, 0, 1); PG8_SCHED; PG8_LDA(At, 0, 0); PG8_STAGE_A(PG8_SA(1, 1), a1, 1, false);
            PG8_WAIT_V(8); PG8_WAIT_L(0); PG8_BAR; PG8_MMA(0, 0, At, B0); PG8_MMA(0, 1, At, B1); PG8_BAR; PG8_SCHED;
            PG8_LDA(At, 0, 1); PG8_STAGE(PG8_SB(0, 0), b2, voffB); PG8_STAGE(PG8_SB(0, 1), b2 + hstepB, voffB); PG8_STAGE_A(PG8_SA(0, 0), a2, 0, last);
            PG8_WAIT_V(8); PG8_WAIT_L(0); PG8_BAR; PG8_MMA(1, 0, At, B0); PG8_MMA(1, 1, At, B1); PG8_BAR; PG8_SCHED;
            PG8_LDB(B0, 1, 0); PG8_LDB(B1, 1, 1); PG8_SCHED; PG8_LDA(At, 1, 0); PG8_STAGE_A(PG8_SA(0, 1), a2, 1, last);
            PG8_WAIT_V(8); PG8_WAIT_L(0); PG8_BAR; PG8_MMA(0, 0, At, B0); PG8_MMA(0, 1, At, B1); PG8_BAR; PG8_SCHED;
            PG8_LDA(At, 1, 1); PG8_STAGE(PG8_SB(1, 0), b3, voffB); PG8_STAGE(PG8_SB(1, 1), b3 + hstepB, voffB); PG8_STAGE_A(PG8_SA(1, 0), a3, 0, last);
            PG8_WAIT_V(8); PG8_WAIT_L(0); PG8_BAR; PG8_MMA(1, 0, At, B0); PG8_MMA(1, 1, At, B1); PG8_BAR; PG8_SCHED;
        }
        if (wr == 0) PG8_BAR;
        { int l_ = lane; asm volatile("" : "+v"(l_)); E(acc, cur, wr, wc, l_ & 15, l_ >> 4); }
        if (!has_next) break;
#pragma unroll
        for (int a = 0; a < 2; ++a)
#pragma unroll
            for (int b = 0; b < 2; ++b)
#pragma unroll
                for (int m = 0; m < 4; ++m)
#pragma unroll
                    for (int n = 0; n < 2; ++n) acc[a][b][m][n] = (f32x4){0.f, 0.f, 0.f, 0.f};
        cur = nxt; cA = nA; cB = nB; ++ui;
        if constexpr (GATHER) {
#pragma unroll
            for (int h = 0; h < 2; ++h)
#pragma unroll
                for (int i = 0; i < 2; ++i) gc[h][i] = gn[h][i]; }
        if (wr == 1) PG8_BAR;
    }
    PG8_WAIT_V(0);
    PG8_BAR;
#undef PG8_SA
#undef PG8_SB
#undef PG8_STAGE
#undef PG8_STAGE_A
#undef PG8_LDA
#undef PG8_LDB
#undef PG8_MMA
#undef PG8_WAIT_V
#undef PG8_WAIT_L
#undef PG8_BAR
#undef PG8_SCHED
}
}
DI float bf2f(bf16_t b) { return __uint_as_float(((unsigned)b) << 16); }

#ifndef EMU8
#define EMU8 0
#endif
DI float q8(float f) { if (EMU8) { unsigned u = __float_as_uint(f); u += 0x7FFFFu + ((u >> 20) & 1u); u &= 0xFFF00000u; return __uint_as_float(u); } return f; }
typedef __bf16 hbf16x2 __attribute__((ext_vector_type(2)));
DI unsigned pk2(float lo, float hi) { const f32x2 v = {lo, hi}; return __builtin_bit_cast(unsigned, __builtin_convertvector(v, hbf16x2)); }
DI float siluf(float x) { return x * __builtin_amdgcn_rcpf(1.0f + __expf(-x)); }
DI float sigmoidf_(float x) { return __builtin_amdgcn_rcpf(1.0f + __expf(-x)); }
DI float softplusf_(float x) { return x > 15.f ? x : __logf(1.0f + __expf(x)); }
DI float wave_sum(float v) {
#pragma unroll
    for (int o = 32; o >= 1; o >>= 1) v += __shfl_xor(v, o);
    return v;
}
DI void unpack8(const u32x4& w, float (&f)[8]) {
    f[0] = __uint_as_float(w.x << 16); f[1] = __uint_as_float(w.x & 0xffff0000u);
    f[2] = __uint_as_float(w.y << 16); f[3] = __uint_as_float(w.y & 0xffff0000u);
    f[4] = __uint_as_float(w.z << 16); f[5] = __uint_as_float(w.z & 0xffff0000u);
    f[6] = __uint_as_float(w.w << 16); f[7] = __uint_as_float(w.w & 0xffff0000u);
}
DI bf16_t f2bf(float f) { return (bf16_t)(pk2(f, 0.f) & 0xffffu); }
DI unsigned pk2q(float lo, float hi) { return pk2(q8(lo), q8(hi)); }
DI u32x4 pack8q(const float (&f)[8]) { u32x4 w; w.x = pk2q(f[0], f[1]); w.y = pk2q(f[2], f[3]); w.z = pk2q(f[4], f[5]); w.w = pk2q(f[6], f[7]); return w; }
DI u32x4 pack8(const float (&f)[8]) { u32x4 w; w.x = pk2(f[0], f[1]); w.y = pk2(f[2], f[3]); w.z = pk2(f[4], f[5]); w.w = pk2(f[6], f[7]); return w; }

constexpr int F8_SH = 3, F8_SACT = 3, F8_SWGU = 10, F8_SWD = 9, F8_SWIN = 10, F8_SWOUT = 10, F8_SY = 1, F8_SYE = 4, F8_SWP = 10, F8_SYT = 2, F8_SCT = 13, F8_SQ = 12, F8_SK = 8, F8_SO = 5;
DI float clamp8(float x) { return __builtin_amdgcn_fmed3f(x, -448.0f, 448.0f); }
typedef float f32x2_ __attribute__((ext_vector_type(2)));
DI f32x4 unpk4f8(unsigned w) { const f32x2_ lo = __builtin_amdgcn_cvt_pk_f32_fp8((int)w, false), hi = __builtin_amdgcn_cvt_pk_f32_fp8((int)w, true); return (f32x4){lo[0], lo[1], hi[0], hi[1]}; }
DI unsigned char f2f8(float a) { return (unsigned char)(__builtin_amdgcn_cvt_pk_fp8_f32(clamp8(a), 0.f, 0, false) & 0xff); }
DI u32x2 f8x4_to_bf16x4(unsigned w) { const f32x4 f = unpk4f8(w); u32x2 o; o.x = (__float_as_uint(f[0]) >> 16) | (__float_as_uint(f[1]) & 0xffff0000u); o.y = (__float_as_uint(f[2]) >> 16) | (__float_as_uint(f[3]) & 0xffff0000u); return o; }
DI unsigned pk4f8(float a, float b, float c, float d) { int w = 0; w = __builtin_amdgcn_cvt_pk_fp8_f32(clamp8(a), clamp8(b), w, false); w = __builtin_amdgcn_cvt_pk_fp8_f32(clamp8(c), clamp8(d), w, true); return (unsigned)w; }

DI bf16x8 lds_frag(const LAS bf16_t* base, int pitch, int row0, int k0, int lane) {
    return *(const LAS bf16x8*)(base + (size_t)(row0 + (lane & 15)) * pitch + k0 + (lane >> 4) * 8);
}
#define MFMA16(a, b, c) __builtin_amdgcn_mfma_f32_16x16x32_bf16((a), (b), (c), 0, 0, 0)

#define CAS __attribute__((address_space(4)))
#define GAS __attribute__((address_space(1)))
typedef const GAS float* cfp_t;
typedef const CAS cfp_t* intab_t;
DI void lds_barrier() { asm volatile("s_waitcnt lgkmcnt(0)" ::: "memory"); __builtin_amdgcn_s_barrier(); asm volatile("" ::: "memory"); }
#ifndef EMUXS
#define EMUXS 0
#endif
DI float rbf(float x) { return EMUXS ? __uint_as_float(pk2(x, 0.f) << 16) : x; }
struct Frame {
    LAS unsigned char* lds; int tid, lane, wave, G, bid;
    intab_t in; float* out; unsigned char* ws; unsigned* ctl;
};
DI const float* INP(const Frame& F, int i) { return (const float*)F.in[i]; }
enum { IN_X = 0, IN_C, IN_CTX, IN_CCTX, IN_ADAW, IN_ADAB, IN_NMIX, IN_NFFN, IN_DNWIN, IN_DNCONV, IN_DNALOG, IN_DNDT, IN_DNNORM, IN_DNWOUT, IN_FNWIN, IN_FNWOUT,
       IN_RW, IN_RB, IN_MG, IN_MU, IN_MD, IN_FNORM };

DI void phase_mod(const Frame& F) {
    LAS float* sc = (LAS float*)F.lds;
    LAS float* red = (LAS float*)(F.lds + 5 * D * 4);
    for (int i = F.tid; i < 5 * D; i += NT) { const int r = i / D, k = i % D; const float v = r < 4 ? INP(F, IN_C)[r * D + k] : INP(F, IN_CCTX)[k]; sc[i] = siluf(v); }
    __syncthreads();
    const int c4 = (F.tid & 15) * 4, ks = F.tid >> 4;
    for (int u = F.bid; u < DEPTH * 192; u += F.G) {
        const int layer = u / 192, n0 = (u % 192) * 64;
        const float* W = INP(F, IN_ADAW) + (size_t)layer * D * (NMOD * D) + n0 + c4;
        f32x4 a0 = {0.f, 0.f, 0.f, 0.f}, a1 = a0, a2 = a0, a3 = a0, a4 = a0;
        const int kb = ks * 64;
        f32x4 wa[4], wb[4];
#define MOD_LOAD(w, k0) _Pragma("unroll") for (int k = 0; k < 4; ++k) w[k] = __builtin_nontemporal_load((const f32x4*)(W + (size_t)(kb + (k0) + k) * (NMOD * D)))
#define MOD_FMA(w, k0) _Pragma("unroll") for (int k = 0; k < 4; ++k) { const int kk = kb + (k0) + k; a0 += w[k] * sc[0 * D + kk]; a1 += w[k] * sc[1 * D + kk]; a2 += w[k] * sc[2 * D + kk]; a3 += w[k] * sc[3 * D + kk]; a4 += w[k] * sc[4 * D + kk]; }
        MOD_LOAD(wa, 0);
#pragma unroll 1
        for (int k0 = 0; k0 < 64; k0 += 8) { MOD_LOAD(wb, k0 + 4); MOD_FMA(wa, k0); if (k0 + 8 < 64) { MOD_LOAD(wa, k0 + 8); } MOD_FMA(wb, k0 + 4); }
#undef MOD_LOAD
#undef MOD_FMA
        *(LAS f32x4*)(red + (ks * 5 + 0) * 64 + c4) = a0; *(LAS f32x4*)(red + (ks * 5 + 1) * 64 + c4) = a1; *(LAS f32x4*)(red + (ks * 5 + 2) * 64 + c4) = a2;
        *(LAS f32x4*)(red + (ks * 5 + 3) * 64 + c4) = a3; *(LAS f32x4*)(red + (ks * 5 + 4) * 64 + c4) = a4;
        __syncthreads();
        if (F.tid < 5 * 64) { const int r = F.tid >> 6, cc = F.tid & 63; float sacc = 0.f;
#pragma unroll
            for (int q = 0; q < 32; ++q) sacc += red[(q * 5 + r) * 64 + cc];
            ((float*)(F.ws + WS_MOD))[((size_t)layer * 5 + r) * (NMOD * D) + n0 + cc] = sacc + INP(F, IN_ADAB)[(size_t)layer * (NMOD * D) + n0 + cc]; }
        __syncthreads();
    }
    {   const float* src = INP(F, IN_FNWIN); bf16_t* dst = (bf16_t*)(F.ws + WS_WB2);
        for (size_t i = ((size_t)F.bid * NT + F.tid) * 8; i < (size_t)2 * D * D; i += (size_t)F.G * NT * 8) {
            const f32x4 a = *(const f32x4*)(src + i), b = *(const f32x4*)(src + i + 4); float f[8] = {a[0], a[1], a[2], a[3], b[0], b[1], b[2], b[3]};
            *(u32x4*)(dst + i) = pack8q(f); } }
    const size_t gt = (size_t)F.bid * NT + F.tid, gs = (size_t)F.G * NT;
    bf16_t* Dt = (bf16_t*)(F.ws + WS_DT);
    for (size_t i = gt; i < (size_t)512 * 512; i += gs) { const int c = (int)(i & 511), jr = (int)(i >> 9);
        const int l = jr <= 256 ? jr : jr - 256; const float a = (float)((l * c) & 511) * (2.0f / 512.0f); const float v = jr <= 256 ? cospif(a) : -sinpif(a); Dt[i] = f2bf(q8(v * 0.04419417382415922f)); }
#if F8FN
    {   unsigned char* CT8 = F.ws + WS_CT;
        for (size_t i16 = gt; i16 < (size_t)4 * 2048 * 2048 / 16; i16 += gs) { const size_t i = i16 * 16; const int t0 = (int)(i & 2047), m = (int)((i >> 11) & 2047), par = (int)((i >> 22) & 1), ty = (int)(i >> 23);
            u32x4 w;
#pragma unroll
            for (int q4 = 0; q4 < 4; ++q4) { float f[4];
#pragma unroll
                for (int k = 0; k < 4; ++k) { const float a = (float)(((2 * m + par) * (t0 + q4 * 4 + k)) & 4095) * (2.0f / 4096.0f); f[k] = (ty ? sinpif(a) : cospif(a)) * ((float)(1 << F8_SCT) / 64.0f); }
                w[q4] = pk4f8(f[0], f[1], f[2], f[3]); }
            *(u32x4*)(CT8 + i) = w; } }
#else
    bf16_t* CT = (bf16_t*)(F.ws + WS_CT);
    for (size_t i8 = gt; i8 < (size_t)4 * 2048 * 2048 / 8; i8 += gs) { const size_t i = i8 * 8; const int t0 = (int)(i & 2047), m = (int)((i >> 11) & 2047), par = (int)((i >> 22) & 1), ty = (int)(i >> 23);
        float f[8];
#pragma unroll
        for (int k = 0; k < 8; ++k) { const float a = (float)(((2 * m + par) * (t0 + k)) & 4095) * (2.0f / 4096.0f); f[k] = q8((ty ? sinpif(a) : cospif(a)) * (1.0f / 64.0f)); }
        *(u32x4*)(CT + i) = pack8(f); }
#endif
    for (size_t d = gt; d < (size_t)D * NEXP / 4; d += gs) { const int L = (int)(d & 63), q = (int)((d >> 6) & 3), ii = (int)((d >> 8) & 3), j = (int)(d >> 10); const int c = (j * 64 + L) * 4 + ii;
        ((f32x4*)(F.ws + WS_RWP))[d] = *(const f32x4*)(INP(F, IN_RW) + (size_t)c * NEXP + q * 4); }
    bf16_t* CT2 = (bf16_t*)(F.ws + WS_CT2);
    for (size_t i = gt; i < (size_t)2 * 256 * 256; i += gs) { const int t = (int)(i & 255), k = (int)((i >> 8) & 255), ty = (int)(i >> 16);
        const float a = (float)((k * t) & 255) * (2.0f / 256.0f); const float v = ty ? sinpif(a) : cospif(a); CT2[i] = f2bf(q8(v * (1.0f / 16.0f))); }
}

struct CvtJob { const float* src; bf16_t* dst; int N, ldd, k0, n0, map, f8; };
DI int cvt_total(int layer) { return ((layer & 1) == 0 ? 16 * 65 + 256 : 256) + 3 * 1024; }
DI void cvt_job(const Frame& F, int layer, int t, CvtJob& J) {
    const bool dn = (layer & 1) == 0; const int j = layer >> 1;
    const int t_in = dn ? 16 * 65 : 0, t_out = 256, t_g = 1024, t_u = 1024;
    int q = t;
    if (q < t_in) { J.src = INP(F, IN_DNWIN) + (size_t)j * D * DN_IN; J.N = DN_IN; J.dst = (bf16_t*)(F.ws + WM_IN); J.ldd = D; J.k0 = (q / 65) * 128; J.n0 = (q % 65) * 128; J.map = 0; J.f8 = F8G1 ? F8_SWIN : 0; return; }
    q -= t_in;
    if (q < t_out) { J.src = (dn ? INP(F, IN_DNWOUT) : INP(F, IN_FNWOUT)) + (size_t)j * D * D; J.N = D; J.dst = (bf16_t*)(F.ws + WM_OUT); J.ldd = D; J.k0 = (q / 16) * 128; J.n0 = (q % 16) * 128; J.map = dn ? 0 : 3; J.f8 = (F8G2 && (dn || F8G2F)) ? F8_SWOUT : 0; return; }
    q -= t_out;
    if (q < t_g) { const int e = q / 64, r = q % 64; J.src = INP(F, IN_MG) + ((size_t)layer * NEXP + e) * D * DFF; J.N = DFF; J.dst = (bf16_t*)(F.ws + WS_WGU + (size_t)e * 1024 * D); J.ldd = D; J.k0 = (r / 4) * 128; J.n0 = (r % 4) * 128; J.map = 1; J.f8 = F8_SWGU; return; }
    q -= t_g;
    if (q < t_u) { const int e = q / 64, r = q % 64; J.src = INP(F, IN_MU) + ((size_t)layer * NEXP + e) * D * DFF; J.N = DFF; J.dst = (bf16_t*)(F.ws + WS_WGU + (size_t)e * 1024 * D); J.ldd = D; J.k0 = (r / 4) * 128; J.n0 = (r % 4) * 128; J.map = 2; J.f8 = F8_SWGU; return; }
    q -= t_u;
    { const int e = q / 64, r = q % 64; J.src = INP(F, IN_MD) + ((size_t)layer * NEXP + e) * DFF * D; J.N = D; J.dst = (bf16_t*)(F.ws + WS_WD + (size_t)e * D * DFF); J.ldd = DFF; J.k0 = (r / 16) * 128; J.n0 = (r % 16) * 128; J.map = 0; J.f8 = F8_SWD; }
}
DI void cvt_load(const CvtJob& J, int kr, int c4, f32x4 (&pv)[8]) {
    const bool inb = J.n0 + c4 < J.N;
#pragma unroll
    for (int jj = 0; jj < 8; ++jj) { const int kk = J.k0 + kr + 16 * jj; f32x4 v = {0.f, 0.f, 0.f, 0.f};
        if (J.map != 3) { if (inb) v = __builtin_nontemporal_load((const f32x4*)(J.src + (size_t)kk * J.N + J.n0 + c4)); }
        else { const int g = kk >> 9, jr = kk & 511, l = jr <= 256 ? jr : jr - 256;
            v = __builtin_nontemporal_load((const f32x4*)(J.src + (size_t)(g * 512 + l) * D + J.n0 + c4));
            if (jr != 0 && jr != 256) { const f32x4 v2 = __builtin_nontemporal_load((const f32x4*)(J.src + (size_t)(g * 512 + 512 - l) * D + J.n0 + c4)); v = jr < 256 ? v + v2 : v - v2; } }
        pv[jj] = v; }
}
DI void phase_cvt(const Frame& F, int layer) {
    const int total = cvt_total(layer);
    LAS float* T = (LAS float*)F.lds;
    const int kr = F.tid >> 5, c4 = (F.tid & 31) * 4;
    f32x4 pv[8]; CvtJob J;
    if (F.bid < total) { cvt_job(F, layer, F.bid, J); cvt_load(J, kr, c4, pv); }
    int buf = 0;
    for (int t = F.bid; t < total; t += F.G, buf ^= 1) {
        LAS float* Tb = T + buf * (128 * 129);
#pragma unroll
        for (int jj = 0; jj < 8; ++jj) { const int k = kr + 16 * jj; Tb[k * 129 + c4 + 0] = pv[jj][0]; Tb[k * 129 + c4 + 1] = pv[jj][1]; Tb[k * 129 + c4 + 2] = pv[jj][2]; Tb[k * 129 + c4 + 3] = pv[jj][3]; }
        const CvtJob C = J;
        if (t + F.G < total) { cvt_job(F, layer, t + F.G, J); cvt_load(J, kr, c4, pv); }
        __syncthreads();
        {   const int n = F.tid >> 2, kq = F.tid & 3;
            const int nn = C.n0 + n; int row = nn; if (C.map == 1) row = (nn >> 7) * 256 + (nn & 127); if (C.map == 2) row = (nn >> 7) * 256 + 128 + (nn & 127);
            if (nn < C.N) {
                if (C.f8) { const float sc8 = __int_as_float((127 + C.f8) << 23); unsigned char* d8 = (unsigned char*)C.dst + (size_t)row * C.ldd + C.k0;
#pragma unroll
                    for (int i = 0; i < 2; ++i) { const int k16 = (kq + 4 * i) * 16; u32x4 w;
#pragma unroll
                        for (int q4 = 0; q4 < 4; ++q4) { const LAS float* tp = Tb + (k16 + q4 * 4) * 129 + n; w[q4] = pk4f8(tp[0] * sc8, tp[129] * sc8, tp[258] * sc8, tp[387] * sc8); }
                        *(u32x4*)(d8 + k16) = w; } }
                else {
#pragma unroll
                for (int i = 0; i < 4; ++i) { const int k8 = (kq + 4 * i) * 8; float f[8];
#pragma unroll
                    for (int jj = 0; jj < 8; ++jj) f[jj] = Tb[(k8 + jj) * 129 + n];
                    *(u32x4*)(C.dst + (size_t)row * C.ldd + C.k0 + k8) = pack8q(f); } } } }
    }
    __syncthreads();
}
constexpr int MISC_OFF = 131072;
DI const float* modp(const Frame& F, int layer, int mrow, int which) { return (const float*)(F.ws + WS_MOD) + ((size_t)layer * 5 + mrow) * (NMOD * D) + (size_t)which * D; }
DI int mod_row(int r) { return r < NLAT ? (r >> 12) : 4; }

DI void moe_prefix_to_lds(const Frame& F, int layer) {
    LAS int* pre = (LAS int*)(F.lds + MISC_OFF);
    if (F.tid < NEXP) pre[32 + F.tid] = (int)__hip_atomic_load(F.ctl + CW_CNT + (layer * NEXP + F.tid) * 64, __ATOMIC_RELAXED, __HIP_MEMORY_SCOPE_AGENT);
    __syncthreads();
    if (F.tid == 0) { int acc = 0;
#pragma unroll
        for (int e = 0; e < NEXP; ++e) { pre[e] = acc; acc += (pre[32 + e] + 255) >> 8; }
        pre[16] = acc; }
    __syncthreads();
}

DI LAS float* tvec(const Frame& F, int idx) { return (LAS float*)F.lds + idx * D; }
DI void thin_fill_vecs(const Frame& F, const float* nw, int layer_mod, int which0, int layer_gate) {
    for (int i = F.tid; i < 16 * (D / 4); i += NT) { const int v = i / (D / 4), c4 = (i % (D / 4)) * 4; const float* src = nullptr;
        if (v == 0) src = nw;
        else { const int mr = (v - 1) / 3, k = (v - 1) % 3; if (k < 2) { if (layer_mod >= 0) src = modp(F, layer_mod, mr, which0 + k); } else if (layer_gate >= 0) src = modp(F, layer_gate, mr, 5); }
        if (src) *(LAS f32x4*)(tvec(F, v) + c4) = *(const f32x4*)(src + c4); }
    __syncthreads();
}
struct Rt { int e1, p1, e2, p2; float w1, w2; };
struct RawRow { u32x2 xs[8]; unsigned ya[8], yb[8]; float w1s, w2s; };
DI Rt rt_load(const Frame& F, int layer, int r) { Rt t = {0, 0, 0, 0, 0.f, 0.f};
    if (layer > 0) { const int* rt = (const int*)(F.ws + WS_ROUTE) + (size_t)r * 8; const u32x4 a = *(const u32x4*)rt; const u32x2 b = *(const u32x2*)(rt + 4);
        t.e1 = (int)a[0]; t.p1 = (int)a[1]; t.e2 = (int)a[2]; t.p2 = (int)a[3]; t.w1 = __uint_as_float(b[0]); t.w2 = __uint_as_float(b[1]); }
    return t; }
DI void raw_xs(const Frame& F, int layer, int r, RawRow& R, f32x4 (&x)[8]) {
    const int c0 = F.lane * 4;
    if (layer == 0) { const float* src = r < NLAT ? INP(F, IN_X) + (size_t)r * D : INP(F, IN_CTX) + (size_t)(r - NLAT) * D;
#pragma unroll
        for (int j = 0; j < 8; ++j) x[j] = *(const f32x4*)(src + j * 256 + c0); }
    else { const bf16_t* src = (const bf16_t*)(F.ws + WS_XS) + (size_t)r * D;
#pragma unroll
        for (int j = 0; j < 8; ++j) R.xs[j] = *(const u32x2*)(src + j * 256 + c0); }
}
DI void raw_y(const Frame& F, int layer, const Rt& t, RawRow& R) {
    if (layer == 0) return;
    const int c0 = F.lane * 4; const LAS int* pre = (const LAS int*)(F.lds + MISC_OFF);
    const unsigned char* y1 = F.ws + WS_YE + ((size_t)pre[t.e1] * 256 + t.p1) * D; const unsigned char* y2 = F.ws + WS_YE + ((size_t)pre[t.e2] * 256 + t.p2) * D;
#pragma unroll
    for (int j = 0; j < 8; ++j) { R.ya[j] = *(const unsigned*)(y1 + j * 256 + c0); R.yb[j] = *(const unsigned*)(y2 + j * 256 + c0); }
    R.w1s = t.w1 * (1.0f / (float)(1 << F8_SYE)); R.w2s = t.w2 * (1.0f / (float)(1 << F8_SYE));
}
DI void raw_finish(const Frame& F, int layer, int r, const RawRow& R, f32x4 (&x)[8]) {
    if (layer == 0) return;
    const int c0 = F.lane * 4; const LAS float* gf = tvec(F, 1 + mod_row(r) * 3 + 2);
#pragma unroll
    for (int j = 0; j < 8; ++j) { const int c = j * 256 + c0; const u32x2 xr = R.xs[j]; const f32x4 g = *(const LAS f32x4*)(gf + c);
        const f32x4 xv = {__uint_as_float(xr.x << 16), __uint_as_float(xr.x & 0xffff0000u), __uint_as_float(xr.y << 16), __uint_as_float(xr.y & 0xffff0000u)};
        x[j] = xv + g * (unpk4f8(R.ya[j]) * R.w1s + unpk4f8(R.yb[j]) * R.w2s); }
}
DI void load_x_pair(const Frame& F, int layer, int rA, int rB, f32x4 (&xA)[8], f32x4 (&xB)[8]) {
    RawRow A, B; const Rt tA = rt_load(F, layer, rA), tB = rt_load(F, layer, rB);
    raw_xs(F, layer, rA, A, xA); raw_xs(F, layer, rB, B, xB);
    raw_y(F, layer, tA, A); raw_y(F, layer, tB, B);
    __builtin_amdgcn_sched_barrier(0);
    raw_finish(F, layer, rA, A, xA); raw_finish(F, layer, rB, B, xB);
}
DI float row_rinv(const f32x4 (&x)[8]) {
    float s = 0.f;
#pragma unroll
    for (int j = 0; j < 8; ++j) s += (x[j][0] * x[j][0] + x[j][1] * x[j][1]) + (x[j][2] * x[j][2] + x[j][3] * x[j][3]);
    s = wave_sum(s);
    return rsqrtf(s * (1.0f / D) + EPS);
}

DI void thin_a_mod(const Frame& F, int r, f32x4 (&h)[8]) {
    bf16_t* xs = (bf16_t*)(F.ws + WS_XS) + (size_t)r * D; const int c0 = F.lane * 4;
#pragma unroll
    for (int j = 0; j < 8; ++j) { u32x2 o; o.x = pk2(h[j][0], h[j][1]); o.y = pk2(h[j][2], h[j][3]); *(u32x2*)(xs + j * 256 + c0) = o; }
    const float rinv = row_rinv(h);
    const LAS float* nw = tvec(F, 0); const LAS float* sh = tvec(F, 1 + mod_row(r) * 3); const LAS float* sc = tvec(F, 1 + mod_row(r) * 3 + 1);
#pragma unroll
    for (int j = 0; j < 8; ++j) { const int c = j * 256 + c0; const f32x4 w = *(const LAS f32x4*)(nw + c), s1 = *(const LAS f32x4*)(sc + c), s0 = *(const LAS f32x4*)(sh + c);
        h[j] = (h[j] * rinv) * w * (s1 + 1.0f) + s0; }
}
DI void thin_a_pair(const Frame& F, int layer, int rA, int rB, f32x4 (&hA)[8], f32x4 (&hB)[8]) { load_x_pair(F, layer, rA, rB, hA, hB); thin_a_mod(F, rA, hA); thin_a_mod(F, rB, hB); }
DI void store_h_row(const Frame& F, int r, const f32x4 (&h)[8], bool f8 = false) {
    const int c0 = F.lane * 4;
    if (f8) { unsigned char* hb = F.ws + WS_HB + (size_t)r * D; const float s = (float)(1 << F8_SH);
#pragma unroll
        for (int j = 0; j < 8; ++j) *(unsigned*)(hb + j * 256 + c0) = pk4f8(h[j][0] * s, h[j][1] * s, h[j][2] * s, h[j][3] * s);
        return; }
    bf16_t* hb = (bf16_t*)(F.ws + WS_HB) + (size_t)r * D;
#pragma unroll
    for (int j = 0; j < 8; ++j) { u32x2 o; o.x = pk2q(h[j][0], h[j][1]); o.y = pk2q(h[j][2], h[j][3]); *(u32x2*)(hb + j * 256 + c0) = o; }
}
DI void phase_thin_a(const Frame& F, int layer, int nrows, bool fold) {
    if (layer > 0) moe_prefix_to_lds(F, layer - 1);
    thin_fill_vecs(F, INP(F, IN_NMIX) + (size_t)layer * D, layer, 0, layer - 1);
    if (fold) {
        for (int pg = F.bid; pg * 8 < NLAT / 2; pg += F.G) { const int p = pg * 8 + F.wave, r1 = (p >> 11) * SEQ + (p & 2047), r2 = r1 + 2048;
            f32x4 h1[8], h2[8]; thin_a_pair(F, layer, r1, r2, h1, h2);
#pragma unroll
            for (int j = 0; j < 8; ++j) { const f32x4 a = h1[j] + h2[j], b = h1[j] - h2[j]; h1[j] = a; h2[j] = b; }
            store_h_row(F, r1, h1, F8FN != 0); store_h_row(F, r2, h2, F8FN != 0); }
        for (int t = F.wave * F.G + F.bid; NLAT + 2 * t < nrows; t += 8 * F.G) { const int r = NLAT + 2 * t; f32x4 h1[8], h2[8]; thin_a_pair(F, layer, r, r + 1, h1, h2); store_h_row(F, r, h1, F8FN != 0); store_h_row(F, r + 1, h2, F8FN != 0); }
    } else {
        for (int t = F.wave * F.G + F.bid; 2 * t < nrows; t += 8 * F.G) { const int r = 2 * t; f32x4 h1[8], h2[8]; thin_a_pair(F, layer, r, r + 1, h1, h2); store_h_row(F, r, h1, F8G1 != 0); store_h_row(F, r + 1, h2, F8G1 != 0); }
    }
}

DI void phase_final(const Frame& F) {
    moe_prefix_to_lds(F, DEPTH - 1);
    thin_fill_vecs(F, INP(F, IN_FNORM), -1, 0, DEPTH - 1);
    const LAS float* nw = tvec(F, 0);
    for (int t = F.wave * F.G + F.bid; 2 * t < NLAT; t += 8 * F.G) {
        const int r = 2 * t; f32x4 xA[8], xB[8];
        load_x_pair(F, DEPTH, r, r + 1, xA, xB);
        const float rinvA = row_rinv(xA), rinvB = row_rinv(xB); const int c0 = F.lane * 4;
        float* o = F.out + (size_t)r * D;
#pragma unroll
        for (int j = 0; j < 8; ++j) { const int c = j * 256 + c0; const f32x4 w = *(const LAS f32x4*)(nw + c); *(f32x4*)(o + c) = (xA[j] * rinvA) * w; *(f32x4*)(o + D + c) = (xB[j] * rinvB) * w; }
    }
}

DI void top2of4(float v0, float v1, float v2, float v3, int& i1, int& i2, float& sc) {
    i1 = 0; float m = v0; if (v1 > m) { m = v1; i1 = 1; } if (v2 > m) { m = v2; i1 = 2; } if (v3 > m) { m = v3; i1 = 3; }
    float m2 = -INFINITY; i2 = 0;
    if (i1 != 0 && v0 > m2) { m2 = v0; i2 = 0; } if (i1 != 1 && v1 > m2) { m2 = v1; i2 = 1; } if (i1 != 2 && v2 > m2) { m2 = v2; i2 = 2; } if (i1 != 3 && v3 > m2) { m2 = v3; i2 = 3; }
    sc = m + m2;
}
DI float pick4(int i, float a, float b, float c, float d) { return i == 0 ? a : (i == 1 ? b : (i == 2 ? c : d)); }

DI void route_row(const Frame& F, const f32x4 (&lg)[4], int r, const float* rb, LAS unsigned* lcount, LAS int* t) {
    float s[16];
#pragma unroll
    for (int q = 0; q < 4; ++q)
#pragma unroll
        for (int k = 0; k < 4; ++k) s[q * 4 + k] = sigmoidf_(wave_sum(lg[q][k]));
    float sel[16];
#pragma unroll
    for (int e = 0; e < 16; ++e) sel[e] = s[e] + rb[e];
    int a1[4], a2[4]; float gs[4];
#pragma unroll
    for (int g = 0; g < 4; ++g) top2of4(sel[4 * g], sel[4 * g + 1], sel[4 * g + 2], sel[4 * g + 3], a1[g], a2[g], gs[g]);
    int gi = 0; float gm = gs[0]; if (gs[1] > gm) { gm = gs[1]; gi = 1; } if (gs[2] > gm) { gm = gs[2]; gi = 2; } if (gs[3] > gm) { gm = gs[3]; gi = 3; }
    const int i1 = gi == 0 ? a1[0] : (gi == 1 ? a1[1] : (gi == 2 ? a1[2] : a1[3]));
    const int i2 = gi == 0 ? a2[0] : (gi == 1 ? a2[1] : (gi == 2 ? a2[2] : a2[3]));
    const float t0 = pick4(gi, s[0], s[4], s[8], s[12]), t1 = pick4(gi, s[1], s[5], s[9], s[13]), t2 = pick4(gi, s[2], s[6], s[10], s[14]), t3 = pick4(gi, s[3], s[7], s[11], s[15]);
    const float sv1 = pick4(i1, t0, t1, t2, t3), sv2 = pick4(i2, t0, t1, t2, t3);
    const float inv = 1.0f / (sv1 + sv2);
    const int e1 = gi * 4 + i1, e2 = gi * 4 + i2;
    if (F.lane == 0) {
        const unsigned p1 = __hip_atomic_fetch_add(lcount + e1, 1u, __ATOMIC_RELAXED, __HIP_MEMORY_SCOPE_WORKGROUP);
        const unsigned p2 = __hip_atomic_fetch_add(lcount + e2, 1u, __ATOMIC_RELAXED, __HIP_MEMORY_SCOPE_WORKGROUP);
        t[0] = e1; t[1] = (int)p1; t[2] = e2; t[3] = (int)p2; t[4] = __float_as_int(sv1 * inv); t[5] = __float_as_int(sv2 * inv); t[6] = r; }
}

#ifndef TBR
#define TBR 2
#endif
DI void phase_thin_b(const Frame& F, int layer, int nrows) {
    LAS f32x4* RW = (LAS f32x4*)F.lds;
    LAS int* tab = (LAS int*)(F.lds + MISC_OFF + 1024);
    LAS unsigned* lcount = (LAS unsigned*)(F.lds + MISC_OFF + 512);
    LAS unsigned* lbase = (LAS unsigned*)(F.lds + MISC_OFF + 640);
    for (int i = F.tid; i < D * NEXP / 4; i += NT) RW[i] = ((const f32x4*)(F.ws + WS_RWP))[i];
    if (F.tid < 16) lcount[F.tid] = 0u;
    __syncthreads();
    const float* nw = INP(F, IN_NFFN) + (size_t)layer * D; const float* rb = INP(F, IN_RB);
    const int ntask = nrows / TBR;
    int it = 0;
    for (int tk = F.wave * F.G + F.bid; tk < ntask; tk += 8 * F.G, ++it) {
        int ln_ = F.lane; asm volatile("" : "+v"(ln_));
        const int r0 = tk * TBR; u32x2 xp[TBR][8]; const int c0 = ln_ * 4;
        {   const bf16_t* xs = (const bf16_t*)(F.ws + WS_XS) + (size_t)r0 * D;
#pragma unroll
            for (int j = 0; j < 8; ++j)
#pragma unroll
                for (int s2 = 0; s2 < TBR; ++s2) xp[s2][j] = *(const u32x2*)(xs + s2 * D + j * 256 + c0); }
#define UNPK(v) ((f32x4){__uint_as_float((v).x << 16), __uint_as_float((v).x & 0xffff0000u), __uint_as_float((v).y << 16), __uint_as_float((v).y & 0xffff0000u)})
        float rinv[TBR];
#pragma unroll
        for (int s2 = 0; s2 < TBR; ++s2) { float ss = 0.f;
#pragma unroll
            for (int j = 0; j < 8; ++j) { const f32x4 a = UNPK(xp[s2][j]); ss += (a[0] * a[0] + a[1] * a[1]) + (a[2] * a[2] + a[3] * a[3]); }
            rinv[s2] = rsqrtf(wave_sum(ss) * (1.0f / D) + EPS); }
        const float* sh = modp(F, layer, mod_row(r0), 3); const float* sc = modp(F, layer, mod_row(r0), 4);
        unsigned char* hb = F.ws + WS_HB + (size_t)r0 * D;
        f32x4 lg[TBR][4];
#pragma unroll
        for (int s2 = 0; s2 < TBR; ++s2)
#pragma unroll
            for (int q = 0; q < 4; ++q) lg[s2][q] = (f32x4){0.f, 0.f, 0.f, 0.f};
#pragma unroll
        for (int jh = 0; jh < 2; ++jh) {
            f32x4 wv[4], s1v[4], s0v[4];
#pragma unroll
            for (int jj = 0; jj < 4; ++jj) { const int c = (jh * 4 + jj) * 256 + c0; wv[jj] = *(const f32x4*)(nw + c); s1v[jj] = *(const f32x4*)(sc + c); s0v[jj] = *(const f32x4*)(sh + c); }
            __builtin_amdgcn_sched_barrier(0);
#pragma unroll
            for (int jj = 0; jj < 4; ++jj) { const int j = jh * 4 + jj; const int c = j * 256 + c0;
                const f32x4 ws1 = wv[jj] * (s1v[jj] + 1.0f); const float s8 = (float)(1 << F8_SH);
                f32x4 h[TBR];
#pragma unroll
                for (int s2 = 0; s2 < TBR; ++s2) { h[s2] = (UNPK(xp[s2][j]) * rinv[s2]) * ws1 + s0v[jj]; *(unsigned*)(hb + s2 * D + c) = pk4f8(h[s2][0] * s8, h[s2][1] * s8, h[s2][2] * s8, h[s2][3] * s8); }
#pragma unroll
                for (int i = 0; i < 4; ++i) { f32x4 rw[4];
#pragma unroll
                    for (int q = 0; q < 4; ++q) rw[q] = RW[((j * 4 + i) * 4 + q) * 64 + ln_];
#pragma unroll
                    for (int q = 0; q < 4; ++q)
#pragma unroll
                        for (int s2 = 0; s2 < TBR; ++s2) lg[s2][q] += rw[q] * h[s2][i];
                    __builtin_amdgcn_sched_barrier(0); } } }
#undef UNPK
#pragma unroll
        for (int s2 = 0; s2 < TBR; ++s2) asm volatile("" : "+v"(lg[s2][0]), "+v"(lg[s2][1]), "+v"(lg[s2][2]), "+v"(lg[s2][3]));
#pragma unroll
        for (int s2 = 0; s2 < TBR; ++s2) route_row(F, lg[s2], r0 + s2, rb, lcount, tab + (it * (8 * TBR) + F.wave * TBR + s2) * 8);
    }
    __syncthreads();
    if (F.tid < 16) lbase[F.tid] = __hip_atomic_fetch_add(F.ctl + CW_CNT + (layer * NEXP + F.tid) * 64, lcount[F.tid], __ATOMIC_RELAXED, __HIP_MEMORY_SCOPE_AGENT);
    __syncthreads();
    const int nloc = ((ntask + 8 * F.G - 1) / (8 * F.G)) * (8 * TBR);
    for (int i = F.tid; i < nloc; i += NT) { const LAS int* t = tab + i * 8; const int r = t[6]; if (((i / (8 * TBR)) * 8 + (i / TBR) % 8) * F.G + F.bid < ntask) {
            const int e1 = t[0], e2 = t[2]; const int p1 = t[1] + (int)lbase[e1], p2 = t[3] + (int)lbase[e2];
            int* rt = (int*)(F.ws + WS_ROUTE) + (size_t)r * 8; rt[0] = e1; rt[1] = p1; rt[2] = e2; rt[3] = p2; rt[4] = t[4]; rt[5] = t[5];
            int* list = (int*)(F.ws + WS_LIST); list[(size_t)e1 * LIST_CAP + p1] = r; list[(size_t)e2 * LIST_CAP + p2] = r; } }
    __syncthreads();
}

DI void phase_dn_out(const Frame& F, int j, int nrows) {
    const float* nw = INP(F, IN_DNNORM) + (size_t)j * HD;
    for (int rg = F.bid; rg * 8 < nrows; rg += F.G) {
        const int r = rg * 8 + F.wave; const int c0 = F.lane * 32;
        const bf16_t* o0 = (const bf16_t*)(F.ws + SC_O) + (size_t)r * D + c0; const bf16_t* o1 = o0 + (size_t)NR * D;
        const bf16_t* gp = (const bf16_t*)(F.ws + SC_P) + (size_t)r * 8192 + 6144 + c0;
        float v[32]; float ss = 0.f;
#if F8O
        {   const unsigned char* p0 = F.ws + SC_O + (size_t)r * D + c0; const unsigned char* p1 = p0 + (size_t)NR * D;
#pragma unroll
            for (int q = 0; q < 2; ++q) { const u32x4 wa = *(const u32x4*)(p0 + q * 16), wb = *(const u32x4*)(p1 + q * 16);
#pragma unroll
                for (int q4 = 0; q4 < 4; ++q4) { const f32x4 a = unpk4f8(wa[q4]), b = unpk4f8(wb[q4]);
#pragma unroll
                    for (int k = 0; k < 4; ++k) { const float x = (a[k] + b[k]) * (1.0f / (float)(1 << F8_SO)); v[q * 16 + q4 * 4 + k] = x; ss += x * x; } } } }
#else
#pragma unroll
        for (int q = 0; q < 4; ++q) { float a[8], b[8]; unpack8(*(const u32x4*)(o0 + q * 8), a); unpack8(*(const u32x4*)(o1 + q * 8), b);
#pragma unroll
            for (int k = 0; k < 8; ++k) { v[q * 8 + k] = a[k] + b[k]; ss += v[q * 8 + k] * v[q * 8 + k]; } }
#endif
        ss += __shfl_xor(ss, 1); ss += __shfl_xor(ss, 2);
        const float rinv = rsqrtf(ss * (1.0f / HD) + EPS);
        const int hc = (F.lane & 3) * 32;
#if F8G2
        unsigned char* y = F.ws + WS_HB + (size_t)r * D + c0;
#pragma unroll
        for (int q = 0; q < 4; q += 2) { u32x4 w;
#pragma unroll
            for (int q2 = 0; q2 < 2; ++q2) { float g[8], o[8]; unpack8(*(const u32x4*)(gp + (q + q2) * 8), g);
#pragma unroll
                for (int k = 0; k < 8; ++k) o[k] = v[(q + q2) * 8 + k] * rinv * nw[hc + (q + q2) * 8 + k] * siluf(g[k]) * (float)(1 << F8_SY);
                w[q2 * 2] = pk4f8(o[0], o[1], o[2], o[3]); w[q2 * 2 + 1] = pk4f8(o[4], o[5], o[6], o[7]); }
            *(u32x4*)(y + q * 8) = w; }
#else
        bf16_t* y = (bf16_t*)(F.ws + WS_HB) + (size_t)r * D + c0;
#pragma unroll
        for (int q = 0; q < 4; ++q) { float g[8], o[8]; unpack8(*(const u32x4*)(gp + q * 8), g);
#pragma unroll
            for (int k = 0; k < 8; ++k) o[k] = v[q * 8 + k] * rinv * nw[hc + q * 8 + k] * siluf(g[k]);
            *(u32x4*)(y + q * 8) = pack8q(o); }
#endif
    }
}
DI int chunk_row0(int b, int cc) { return cc < 4 ? NLAT + b * CTXL + cc * 64 : b * SEQ + (cc - 4) * 64; }

#ifndef DREP
#define DREP 0
#endif
DI void phase_dn_a(const Frame& F, int j) {
    LAS bf16_t* qn = (LAS bf16_t*)F.lds;
    LAS bf16_t* kTl = (LAS bf16_t*)F.lds;
    LAS bf16_t* kn = (LAS bf16_t*)(F.lds + 18432);
    LAS bf16_t* vTl = (LAS bf16_t*)(F.lds + 35840);
    LAS float* KK = (LAS float*)(F.lds + 54272);
    LAS float* QK = KK + 64 * 65;
    LAS bf16_t* TmB = (LAS bf16_t*)(F.lds + 54272);
    LAS bf16_t* TmW = TmB + 64 * 72;
    LAS float* Lm = (LAS float*)(F.lds + 87552);
    LAS float* gv = (LAS float*)(F.lds + 122368);
    LAS float* abv = (LAS float*)(F.lds + 124416);
    LAS float* cwl = (LAS float*)(F.lds + 125440);
    LAS float* Mb = cwl;
    LAS bf16_t* raw = (LAS bf16_t*)(F.lds + 54272);
    const bf16_t* P = (const bf16_t*)(F.ws + SC_P); const float* AB = (const float*)(F.ws + SC_AB);
    const float* cw = INP(F, IN_DNCONV) + (size_t)j * 5 * 6144;
    u32x4 pr[6], ph; f32x4 pcw; float pab;
#define DNA_PREFETCH(uu) do { const int pb_ = (uu) / (HEADS * NCH), ph_ = ((uu) / NCH) % HEADS, pc_ = (uu) % NCH; const int prow_ = chunk_row0(pb_, pc_); \
        _Pragma("unroll") for (int i_ = 0; i_ < 6; ++i_) { const int it_ = i_ * NT + ptid, w_ = it_ & 1023; \
            pr[i_] = *(const u32x4*)(P + (size_t)(prow_ + (w_ >> 4)) * 8192 + (it_ >> 10) * 2048 + ph_ * HD + (w_ & 15) * 8); } \
        ph = (u32x4){0u, 0u, 0u, 0u}; \
        if (ptid < 192) { const int rr_ = (ptid >> 4) & 3, tt_ = rr_ < 2 ? rr_ - 2 : 62 + rr_; const int pos_ = pc_ * 64 + tt_; \
            if (pc_ < 4 && pos_ >= 0 && pos_ < CTXL) ph = *(const u32x4*)(P + (size_t)(prow_ + tt_) * 8192 + (ptid >> 6) * 2048 + ph_ * HD + (ptid & 15) * 8); } \
        pab = 0.f; if (ptid < 256) pab = AB[(size_t)(prow_ + (ptid & 63)) * 64 + (ptid >> 6) * 16 + ph_]; \
        pcw = (f32x4){0.f, 0.f, 0.f, 0.f}; if (ptid < 480) { const int ix_ = ptid * 4, tap_ = ix_ / 384, c_ = ix_ % 384; pcw = *(const f32x4*)(cw + tap_ * 6144 + (c_ >> 7) * 2048 + ph_ * HD + (c_ & 127)); } } while (0)
    { int ptid = F.tid; asm volatile("" : "+v"(ptid)); if (F.bid < NUNIT) DNA_PREFETCH(F.bid); }
    for (int u = F.bid; u < NUNIT; u += F.G) {
        int tid = F.tid;
#define REOPQ() asm volatile("" : "+v"(tid)); const int lane = tid & 63, quad = lane >> 4, l15 = lane & 15; (void)quad; (void)l15; (void)lane;
        const int h = (u / NCH) % HEADS;
        { REOPQ()
#pragma unroll
        for (int i = 0; i < 6; ++i) { const int it = i * NT + tid, w = it & 1023; *(LAS u32x4*)(raw + ((it >> 10) * 68 + (w >> 4) + 2) * 128 + (w & 15) * 8) = pr[i]; }
        if (tid < 192) { const int rr = (tid >> 4) & 3; *(LAS u32x4*)(raw + ((tid >> 6) * 68 + (rr < 2 ? rr : 64 + rr)) * 128 + (tid & 15) * 8) = ph; }
        if (tid < 256) abv[tid] = pab;
        if (tid < 480) *(LAS f32x4*)(cwl + tid * 4) = pcw;
        lds_barrier();
        { const int ptid = tid; if (u + F.G < NUNIT) DNA_PREFETCH(u + F.G); }
        }{ REOPQ()
        for (int rep_ = 0; rep_ < ((DREP >> 0) & 1) + 1; ++rep_) {
#pragma unroll
        for (int part = 0; part < 3; ++part) {
            const int cg = tid & 15;
            f32x2 wt[5][4];
#pragma unroll
            for (int dt = 0; dt < 5; ++dt) { const f32x4 w0 = *(const LAS f32x4*)(cwl + dt * 384 + part * 128 + cg * 8), w1 = *(const LAS f32x4*)(cwl + dt * 384 + part * 128 + cg * 8 + 4);
                wt[dt][0] = (f32x2){w0[0], w0[1]}; wt[dt][1] = (f32x2){w0[2], w0[3]}; wt[dt][2] = (f32x2){w1[0], w1[1]}; wt[dt][3] = (f32x2){w1[2], w1[3]}; }
#pragma unroll
            for (int sub = 0; sub < 2; ++sub) {
                const int t = (sub * NT + tid) >> 4;
                u32x4 rv[5];
#pragma unroll
                for (int dt = 0; dt < 5; ++dt) rv[dt] = *(const LAS u32x4*)(raw + (part * 68 + t + dt) * 128 + cg * 8);
                __builtin_amdgcn_sched_barrier(0);
                f32x2 acc[4] = {{0.f, 0.f}, {0.f, 0.f}, {0.f, 0.f}, {0.f, 0.f}};
#pragma unroll
                for (int dt = 0; dt < 5; ++dt) {
                    const f32x2 v0 = {__uint_as_float(rv[dt].x << 16), __uint_as_float(rv[dt].x & 0xffff0000u)}, v1 = {__uint_as_float(rv[dt].y << 16), __uint_as_float(rv[dt].y & 0xffff0000u)};
                    const f32x2 v2 = {__uint_as_float(rv[dt].z << 16), __uint_as_float(rv[dt].z & 0xffff0000u)}, v3 = {__uint_as_float(rv[dt].w << 16), __uint_as_float(rv[dt].w & 0xffff0000u)};
                    acc[0] = __builtin_elementwise_fma(v0, wt[dt][0], acc[0]); acc[1] = __builtin_elementwise_fma(v1, wt[dt][1], acc[1]);
                    acc[2] = __builtin_elementwise_fma(v2, wt[dt][2], acc[2]); acc[3] = __builtin_elementwise_fma(v3, wt[dt][3], acc[3]); }
                f32x2 ss2 = {0.f, 0.f};
#pragma unroll
                for (int k = 0; k < 4; ++k) { f32x2 e; e.x = __builtin_amdgcn_rcpf(1.0f + __expf(-acc[k].x)); e.y = __builtin_amdgcn_rcpf(1.0f + __expf(-acc[k].y)); acc[k] = acc[k] * e; ss2 = __builtin_elementwise_fma(acc[k], acc[k], ss2); }
                if (part < 2) { float ss = ss2.x + ss2.y; ss += __shfl_xor(ss, 1); ss += __shfl_xor(ss, 2); ss += __shfl_xor(ss, 4); ss += __shfl_xor(ss, 8);
                    const float scl = rsqrtf(ss + EPS) * (part == 0 ? 0.08838834764831845f : 1.0f);
                    u32x4 o; o.x = pk2(acc[0].x * scl, acc[0].y * scl); o.y = pk2(acc[1].x * scl, acc[1].y * scl); o.z = pk2(acc[2].x * scl, acc[2].y * scl); o.w = pk2(acc[3].x * scl, acc[3].y * scl);
                    *(LAS u32x4*)((part == 0 ? qn : kn) + t * 136 + cg * 8) = o;
                } else {
#pragma unroll
                    for (int k = 0; k < 4; ++k) { const unsigned pw_ = pk2(acc[k].x, acc[k].y); vTl[(cg * 8 + 2 * k) * 72 + t] = (bf16_t)(pw_ & 0xffffu); vTl[(cg * 8 + 2 * k + 1) * 72 + t] = (bf16_t)(pw_ >> 16); }
                }
            }
        }
        }
        lds_barrier();
        }{ REOPQ()
        if (F.wave < 2) { const int d = F.wave, t = lane;
            const float a = abv[d * 64 + t], bb = abv[128 + d * 64 + t];
            const float Al = __expf(INP(F, IN_DNALOG)[(j * 2 + d) * HEADS + h]), dtb = INP(F, IN_DNDT)[(j * 2 + d) * HEADS + h];
            float g = -Al * softplusf_(a + dtb);
            if (d == 0) {
#pragma unroll
                for (int o = 1; o < 64; o <<= 1) { const float tv = __shfl_up(g, o); if (t >= o) g += tv; }
            } else {
#pragma unroll
                for (int o = 1; o < 64; o <<= 1) { const float tv = __shfl_down(g, o); if (t + o < 64) g += tv; }
            }
            const float be = sigmoidf_(bb);
            gv[d * 64 + t] = g; gv[128 + d * 64 + t] = be; gv[256 + d * 64 + t] = be * __expf(g); }
        }{ REOPQ()
        for (int rep_ = 0; rep_ < ((DREP >> 1) & 1) + 1; ++rep_) {
        {   const int mat = F.wave >> 2, tr = F.wave & 3; const LAS bf16_t* Ap = mat ? qn : kn; LAS float* Out = mat ? QK : KK;
            bf16x8 fa[4], fb[4][4];
#pragma unroll
            for (int ks = 0; ks < 4; ++ks) { fa[ks] = lds_frag(Ap, 136, tr * 16, ks * 32, lane);
#pragma unroll
                for (int tc = 0; tc < 4; ++tc) fb[tc][ks] = lds_frag(kn, 136, tc * 16, ks * 32, lane); }
            __builtin_amdgcn_sched_barrier(0);
#pragma unroll
            for (int tc = 0; tc < 4; ++tc) { f32x4 acc = {0.f, 0.f, 0.f, 0.f};
#pragma unroll
                for (int ks = 0; ks < 4; ++ks) acc = MFMA16(fa[ks], fb[tc][ks], acc);
#pragma unroll
                for (int jj = 0; jj < 4; ++jj) Out[(tr * 16 + 4 * quad + jj) * 65 + tc * 16 + l15] = acc[jj]; }
#if F8QK
            {   unsigned char* QN8 = F.ws + SC_QN; const int t = tid >> 3, c16 = (tid & 7) * 16; const float sq = (float)(1 << F8_SQ);
                float fa_[8], fb_[8]; { const u32x4 a_ = *(const LAS u32x4*)(qn + t * 136 + c16), b_ = *(const LAS u32x4*)(qn + t * 136 + c16 + 8); unpack8(a_, fa_); unpack8(b_, fb_); }
                u32x4 w; w.x = pk4f8(fa_[0] * sq, fa_[1] * sq, fa_[2] * sq, fa_[3] * sq); w.y = pk4f8(fa_[4] * sq, fa_[5] * sq, fa_[6] * sq, fa_[7] * sq);
                w.z = pk4f8(fb_[0] * sq, fb_[1] * sq, fb_[2] * sq, fb_[3] * sq); w.w = pk4f8(fb_[4] * sq, fb_[5] * sq, fb_[6] * sq, fb_[7] * sq);
                *(u32x4*)(QN8 + ((size_t)u * 64 + t) * 128 + c16) = w; } }
#else
            bf16_t* QN = (bf16_t*)(F.ws + SC_QN);
#pragma unroll
            for (int i = 0; i < 2; ++i) { const int item = tid + NT * i, t = item >> 4, c8 = item & 15;
                *(u32x4*)(QN + ((size_t)u * 64 + t) * 128 + c8 * 8) = *(const LAS u32x4*)(qn + t * 136 + c8 * 8); } }
#endif
        }
        lds_barrier();
        }{ REOPQ()
        for (int rep_ = 0; rep_ < ((DREP >> 2) & 1) + 1; ++rep_) {
        {   const int c = tid >> 3, s0 = (tid & 7) * 8;
            const float gfc = gv[c], gbc = gv[64 + c], bfc = gv[128 + c], bbc = gv[192 + c];
            float af[8], ab[8], kkv[8], qkv[8], gfs[8], gbs[8];
#pragma unroll
            for (int k = 0; k < 8; ++k) { kkv[k] = KK[c * 65 + s0 + k]; qkv[k] = QK[c * 65 + s0 + k]; gfs[k] = gv[s0 + k]; gbs[k] = gv[64 + s0 + k]; }
            __builtin_amdgcn_sched_barrier(0);
#pragma unroll
            for (int k = 0; k < 8; ++k) { const int sx = s0 + k; const float kk = kkv[k], qk = qkv[k];
                const float df = __expf(sx <= c ? gfc - gfs[k] : 0.f), db = __expf(sx >= c ? gbc - gbs[k] : 0.f);
                Lm[c * 68 + sx] = sx < c ? bfc * kk * df : 0.f;
                Lm[4352 + (63 - c) * 68 + (63 - sx)] = sx > c ? bbc * kk * db : 0.f;
                af[k] = sx <= c ? qk * df : 0.f; ab[k] = sx >= c ? qk * db : 0.f; }
            bf16_t* AI = (bf16_t*)(F.ws + SC_AI);
            *(u32x4*)(AI + ((size_t)u * 64 + c) * 64 + s0) = pack8(af);
            *(u32x4*)(AI + ((size_t)(NUNIT + u) * 64 + c) * 64 + s0) = pack8(ab);
            if (tid < 128) ((float*)(F.ws + SC_G))[((size_t)(tid >> 6) * NUNIT + u) * 64 + (tid & 63)] = gv[tid];
            bf16_t* KT = (bf16_t*)(F.ws + SC_KT);
#pragma unroll
            for (int i = 0; i < 2; ++i) { const int item = tid + NT * i; const int dk = item & 127, tg = item >> 7; unsigned short hv[8];
#pragma unroll
                for (int k = 0; k < 8; ++k) hv[k] = kn[(tg * 8 + k) * 136 + dk];
                u32x4 pk_; pk_.x = (unsigned)hv[0] | ((unsigned)hv[1] << 16); pk_.y = (unsigned)hv[2] | ((unsigned)hv[3] << 16); pk_.z = (unsigned)hv[4] | ((unsigned)hv[5] << 16); pk_.w = (unsigned)hv[6] | ((unsigned)hv[7] << 16);
#if F8QK
                {   float f_[8]; unpack8(pk_, f_); const float sk = (float)(1 << F8_SK); u32x2 w8; w8.x = pk4f8(f_[0] * sk, f_[1] * sk, f_[2] * sk, f_[3] * sk); w8.y = pk4f8(f_[4] * sk, f_[5] * sk, f_[6] * sk, f_[7] * sk);
                    *(u32x2*)((unsigned char*)KT + ((size_t)u * 128 + dk) * 64 + tg * 8) = w8; }
#else
                *(u32x4*)(KT + ((size_t)u * 128 + dk) * 64 + tg * 8) = pk_;
#endif
                *(LAS u32x4*)(kTl + dk * 72 + tg * 8) = pk_; } }
        }
        lds_barrier();
        }{ REOPQ()
        for (int rep_ = 0; rep_ < ((DREP >> 3) & 1) + 1; ++rep_) {
        {
            if (tid < 128) { const int d = tid >> 6, blk = (tid >> 4) & 3, col = tid & 15; LAS float* Lb = Lm + d * 4352 + (blk * 16) * 68 + blk * 16; float x[16];
#pragma unroll
                for (int rg = 0; rg < 4; ++rg) { f32x4 lr[4][4];
#pragma unroll
                    for (int a_ = 0; a_ < 4; ++a_)
#pragma unroll
                        for (int q = 0; q <= rg; ++q) lr[a_][q] = *(const LAS f32x4*)(Lb + (rg * 4 + a_) * 68 + q * 4);
                    __builtin_amdgcn_sched_barrier(0);
#pragma unroll
                    for (int a_ = 0; a_ < 4; ++a_) { const int r = rg * 4 + a_; float acc = (r == col) ? 1.0f : 0.0f;
#pragma unroll
                        for (int sx = 0; sx < r; ++sx) acc -= lr[a_][sx >> 2][sx & 3] * x[sx];
                        x[r] = acc; } }
#pragma unroll
                for (int r = 0; r < 16; ++r) Lb[r * 68 + col] = x[r]; }
            lds_barrier();
#pragma unroll 1
            for (int i = 1; i < 4; ++i) {
                const int nstrip = i * 64;
                if (tid < 2 * nstrip) { const int d = tid >= nstrip ? 1 : 0, rem = tid - d * nstrip, jb = rem >> 6, r = (rem >> 2) & 15, c4 = (rem & 3) * 4;
                    const LAS float* Lr = Lm + d * 4352 + (i * 16 + r) * 68; const LAS float* Tc = Lm + d * 4352 + jb * 16 + c4; f32x4 acc = {0.f, 0.f, 0.f, 0.f};
#pragma unroll 1
                    for (int kb = jb; kb < i; ++kb) { f32x4 lv[4], tv4[16];
#pragma unroll
                        for (int q = 0; q < 4; ++q) lv[q] = *(const LAS f32x4*)(Lr + kb * 16 + q * 4);
#pragma unroll
                        for (int q = 0; q < 16; ++q) tv4[q] = *(const LAS f32x4*)(Tc + (kb * 16 + q) * 68);
                        __builtin_amdgcn_sched_barrier(0);
#pragma unroll
                        for (int q = 0; q < 16; ++q) acc += tv4[q] * lv[q >> 2][q & 3]; }
                    *(LAS f32x4*)(Mb + ((d * 3 + jb) * 16 + r) * 16 + c4) = acc; }
                lds_barrier();
                if (tid < 2 * nstrip) { const int d = tid >= nstrip ? 1 : 0, rem = tid - d * nstrip, jb = rem >> 6, r = (rem >> 2) & 15, c4 = (rem & 3) * 4;
                    const LAS float* Dr = Lm + d * 4352 + (i * 16 + r) * 68 + i * 16; const LAS float* Mc = Mb + (d * 3 + jb) * 256 + c4; f32x4 lv[4], mv[16];
#pragma unroll
                    for (int q = 0; q < 4; ++q) lv[q] = *(const LAS f32x4*)(Dr + q * 4);
#pragma unroll
                    for (int q = 0; q < 16; ++q) mv[q] = *(const LAS f32x4*)(Mc + q * 16);
                    __builtin_amdgcn_sched_barrier(0);
                    f32x4 acc = {0.f, 0.f, 0.f, 0.f};
#pragma unroll
                    for (int q = 0; q < 16; ++q) acc += mv[q] * lv[q >> 2][q & 3];
                    *(LAS f32x4*)(Lm + d * 4352 + (i * 16 + r) * 68 + jb * 16 + c4) = -acc; }
                lds_barrier();
            } }
        }
        }{ REOPQ()
        for (int rep_ = 0; rep_ < ((DREP >> 4) & 1) + 1; ++rep_) {
#pragma unroll 1
        for (int d = 0; d < 2; ++d) {
            {   const int r = tid >> 3, c0 = (tid & 7) * 8; float tv[8];
                { const f32x4 t0 = *(const LAS f32x4*)(Lm + d * 4352 + r * 68 + c0), t1 = *(const LAS f32x4*)(Lm + d * 4352 + r * 68 + c0 + 4);
                  tv[0] = t0[0]; tv[1] = t0[1]; tv[2] = t0[2]; tv[3] = t0[3]; tv[4] = t1[0]; tv[5] = t1[1]; tv[6] = t1[2]; tv[7] = t1[3]; }
                __builtin_amdgcn_sched_barrier(0);
                const int rr = d ? 63 - r : r, cb = d ? 56 - c0 : c0;
                const f32x4 b0 = *(const LAS f32x4*)(gv + 128 + d * 64 + cb), b1 = *(const LAS f32x4*)(gv + 128 + d * 64 + cb + 4), w0 = *(const LAS f32x4*)(gv + 256 + d * 64 + cb), w1 = *(const LAS f32x4*)(gv + 256 + d * 64 + cb + 4);
                float ob[8], ow[8];
#pragma unroll
                for (int k = 0; k < 8; ++k) { const float v = d ? tv[7 - k] : tv[k]; const float be = k < 4 ? b0[k] : b1[k - 4], bw = k < 4 ? w0[k] : w1[k - 4]; ob[k] = v * be; ow[k] = v * bw; }
                *(LAS u32x4*)(TmB + rr * 72 + cb) = pack8(ob); *(LAS u32x4*)(TmW + rr * 72 + cb) = pack8(ow); }
            lds_barrier();
            if (F.wave < 4) { const int tr = F.wave; bf16_t* UT = (bf16_t*)(F.ws + SC_UT) + ((size_t)d * NUNIT + u) * 128 * 64;
                bf16x8 fa[2], fb[8][2];
#pragma unroll
                for (int ks = 0; ks < 2; ++ks) { fa[ks] = lds_frag(TmB, 72, tr * 16, ks * 32, lane);
#pragma unroll
                    for (int tc = 0; tc < 8; ++tc) fb[tc][ks] = lds_frag(vTl, 72, tc * 16, ks * 32, lane); }
                __builtin_amdgcn_sched_barrier(0);
#pragma unroll
                for (int tc = 0; tc < 8; ++tc) { f32x4 acc = {0.f, 0.f, 0.f, 0.f};
#pragma unroll
                    for (int ks = 0; ks < 2; ++ks) acc = MFMA16(fa[ks], fb[tc][ks], acc);
                    u32x2 o; o.x = pk2(acc[0], acc[1]); o.y = pk2(acc[2], acc[3]);
                    *(u32x2*)(UT + (size_t)(tc * 16 + l15) * 64 + tr * 16 + 4 * quad) = o; }
            } else { const int tcc = F.wave - 4; bf16_t* W = (bf16_t*)(F.ws + SC_W) + ((size_t)d * NUNIT + u) * 64 * 128;
                bf16x8 fb[2], fa[8][2];
#pragma unroll
                for (int ks = 0; ks < 2; ++ks) { fb[ks] = lds_frag(TmW, 72, tcc * 16, ks * 32, lane);
#pragma unroll
                    for (int tn = 0; tn < 8; ++tn) fa[tn][ks] = lds_frag(kTl, 72, tn * 16, ks * 32, lane); }
                __builtin_amdgcn_sched_barrier(0);
#pragma unroll
                for (int tn = 0; tn < 8; ++tn) { f32x4 acc = {0.f, 0.f, 0.f, 0.f};
#pragma unroll
                    for (int ks = 0; ks < 2; ++ks) acc = MFMA16(fa[tn][ks], fb[ks], acc);
                    u32x2 o; o.x = pk2(acc[0], acc[1]); o.y = pk2(acc[2], acc[3]);
                    *(u32x2*)(W + (size_t)(tcc * 16 + l15) * 128 + tn * 16 + 4 * quad) = o; }
            }
            lds_barrier();
        }
        }
        }
#undef REOPQ
    }
#undef DNA_PREFETCH
}

#ifndef DNB_EXTRA
#define DNB_EXTRA 0
#endif
struct DnbSet { u32x4 pw[2], pq[2], pk[2], pa, pu; float pg; };
DI void phase_dn_b(const Frame& F, int jq) {
    LAS bf16_t* St = (LAS bf16_t*)F.lds;
    LAS bf16_t* wl = St + 64 * 136;
    LAS bf16_t* ql = wl + 64 * 136;
    LAS bf16_t* kTl = ql + 64 * 136;
    LAS bf16_t* ail = kTl + 128 * 72;
    LAS bf16_t* uTl = ail + 64 * 72;
    LAS bf16_t* vnT = uTl + 64 * 72;
    LAS bf16_t* vn2T = vnT + 64 * 72;
    LAS float* gl = (LAS float*)(vn2T + 64 * 72);
    const int quad = F.lane >> 4, l15 = F.lane & 15;
    LAS int* claim = (LAS int*)(vn2T + 64 * 72) + 64;
    const unsigned myx = xb_xcc_id() & 7u;
    for (int tries = 0;; ++tries) {
        if (F.tid == 0) { int got = -1;
            for (unsigned k = 0; k < 8u && got < 0; ++k) { const unsigned y = (myx + k) & 7u; unsigned* qh = F.ctl + CW_DNQ + (jq * 16 + (int)y) * 64;
                if (__hip_atomic_load(qh, __ATOMIC_RELAXED, __HIP_MEMORY_SCOPE_AGENT) < 32u) { const unsigned r = __hip_atomic_fetch_add(qh, 1u, __ATOMIC_RELAXED, __HIP_MEMORY_SCOPE_AGENT); if (r < 32u) got = (int)(y * 32u + r); } }
            claim[0] = got; }
        lds_barrier();
        const int u2 = claim[0];
        lds_barrier();
        if (u2 < 0) break;
        const int half = u2 & 1, chain = u2 >> 1;
        const int b = chain >> 5, h = (chain >> 1) & 15, d = chain & 1;
        f32x4 sacc[4];
#pragma unroll
        for (int tc = 0; tc < 4; ++tc) sacc[tc] = (f32x4){0.f, 0.f, 0.f, 0.f};
        for (int i = F.tid; i < 64 * 136 / 2; i += NT) ((LAS unsigned*)St)[i] = 0u;
        DnbSet R0;
#define DNB_CC(step) (d == 0 ? (step) : ((step) < 4 ? 3 - (step) : 71 - (step)))
#define DNB_PREFETCH(R, step) do { const int cc_ = DNB_CC(step); const size_t uu = (size_t)(b * HEADS + h) * NCH + cc_; \
            const bf16_t* Wg = (const bf16_t*)(F.ws + SC_W) + ((size_t)d * NUNIT + uu) * 8192; const bf16_t* Qg = (const bf16_t*)(F.ws + SC_QN) + uu * 8192; \
            const bf16_t* Kg = (const bf16_t*)(F.ws + SC_KT) + uu * 8192; const bf16_t* Ag = (const bf16_t*)(F.ws + SC_AI) + ((size_t)d * NUNIT + uu) * 4096; \
            const bf16_t* Ug = (const bf16_t*)(F.ws + SC_UT) + ((size_t)d * NUNIT + uu) * 8192 + (size_t)half * 64 * 64; \
            _Pragma("unroll") for (int i = 0; i < 2; ++i) { R.pw[i] = *(const u32x4*)(Wg + (size_t)(F.tid + NT * i) * 8); } \
            if (F8QK) { R.pq[0] = *(const u32x4*)((const unsigned char*)(F.ws + SC_QN) + uu * 8192 + (size_t)F.tid * 16); R.pk[0] = *(const u32x4*)((const unsigned char*)(F.ws + SC_KT) + uu * 8192 + (size_t)F.tid * 16); } \
            else { _Pragma("unroll") for (int i = 0; i < 2; ++i) { R.pq[i] = *(const u32x4*)(Qg + (size_t)(F.tid + NT * i) * 8); R.pk[i] = *(const u32x4*)(Kg + (size_t)(F.tid + NT * i) * 8); } } \
            R.pa = *(const u32x4*)(Ag + (size_t)F.tid * 8); R.pu = *(const u32x4*)(Ug + (size_t)F.tid * 8); \
            if (DNB_EXTRA) { const bf16_t* Xg = (const bf16_t*)(F.ws + SC_W) + ((size_t)(1 - d) * NUNIT + ((uu + 1088 + half * 2176) % NUNIT)) * 8192; _Pragma("unroll") for (int i = 0; i < 2; ++i) { const u32x4 dm = *(const u32x4*)(Xg + (size_t)(F.tid + NT * i) * 8); asm volatile("" :: "v"(dm)); } } \
            R.pg = 0.f; if (F.tid < 64) R.pg = ((const float*)(F.ws + SC_G))[((size_t)d * NUNIT + uu) * 64 + F.tid]; } while (0)
#define DNB_STEP(R, step) do { \
            const int cc = DNB_CC(step); const int row0 = chunk_row0(b, cc); \
            _Pragma("unroll") for (int i = 0; i < 2; ++i) { const int item = F.tid + NT * i; \
                *(LAS u32x4*)(wl + (item >> 4) * 136 + (item & 15) * 8) = R.pw[i]; \
                if (!F8QK) { *(LAS u32x4*)(ql + (item >> 4) * 136 + (item & 15) * 8) = R.pq[i]; *(LAS u32x4*)(kTl + (item >> 3) * 72 + (item & 7) * 8) = R.pk[i]; } } \
            if (F8QK) { _Pragma("unroll") for (int hh = 0; hh < 2; ++hh) { const u32x2 q0 = f8x4_to_bf16x4(R.pq[0][hh * 2]), q1 = f8x4_to_bf16x4(R.pq[0][hh * 2 + 1]), k0 = f8x4_to_bf16x4(R.pk[0][hh * 2]), k1 = f8x4_to_bf16x4(R.pk[0][hh * 2 + 1]); \
                    *(LAS u32x4*)(ql + (F.tid >> 3) * 136 + (F.tid & 7) * 16 + hh * 8) = (u32x4){q0.x, q0.y, q1.x, q1.y}; *(LAS u32x4*)(kTl + (F.tid >> 2) * 72 + (F.tid & 3) * 16 + hh * 8) = (u32x4){k0.x, k0.y, k1.x, k1.y}; } } \
            *(LAS u32x4*)(ail + (F.tid >> 3) * 72 + (F.tid & 7) * 8) = R.pa; *(LAS u32x4*)(uTl + (F.tid >> 3) * 72 + (F.tid & 7) * 8) = R.pu; \
            if (F.tid < 64) gl[F.tid] = R.pg; \
            lds_barrier();                                                                \
            if ((step) + 1 < NCH) DNB_PREFETCH(R, (step) + 1); \
            const int trt = F.wave & 3, tc0 = (F.wave >> 2) * 2; const int tk = trt * 16 + 4 * quad; \
              \
            bf16x8 aw[4], bs[2][4]; u32x2 uu2[2]; \
            _Pragma("unroll") for (int ks = 0; ks < 4; ++ks) { aw[ks] = lds_frag(wl, 136, trt * 16, ks * 32, F.lane); bs[0][ks] = lds_frag(St, 136, tc0 * 16, ks * 32, F.lane); bs[1][ks] = lds_frag(St, 136, tc0 * 16 + 16, ks * 32, F.lane); } \
            _Pragma("unroll") for (int q = 0; q < 2; ++q) uu2[q] = *(const LAS u32x2*)(uTl + ((tc0 + q) * 16 + l15) * 72 + tk); \
            const float glast = d == 0 ? gl[63] : gl[0]; \
            const float ksc_ = F8QK ? 1.0f / (float)(1 << F8_SK) : 1.0f, qsc_ = F8QK ? 1.0f / (float)(1 << F8_SQ) : 1.0f;     \
            const float e0 = __expf(glast - gl[tk]) * ksc_, e1 = __expf(glast - gl[tk + 1]) * ksc_, e2 = __expf(glast - gl[tk + 2]) * ksc_, e3 = __expf(glast - gl[tk + 3]) * ksc_; \
            const float eg = __expf(gl[trt * 16 + l15]) * qsc_, gS = __expf(glast); \
            __builtin_amdgcn_sched_barrier(0); \
              \
            {   f32x4 a0 = {0.f, 0.f, 0.f, 0.f}, a1 = {0.f, 0.f, 0.f, 0.f}; \
                _Pragma("unroll") for (int ks = 0; ks < 4; ++ks) { a0 = MFMA16(aw[ks], bs[0][ks], a0); a1 = MFMA16(aw[ks], bs[1][ks], a1); } \
                _Pragma("unroll") for (int q = 0; q < 2; ++q) { const f32x4 acc = q ? a1 : a0; const int dv = (tc0 + q) * 16 + l15; \
                    const float v0 = __uint_as_float(uu2[q].x << 16) - acc[0], v1 = __uint_as_float(uu2[q].x & 0xffff0000u) - acc[1], v2 = __uint_as_float(uu2[q].y << 16) - acc[2], v3 = __uint_as_float(uu2[q].y & 0xffff0000u) - acc[3]; \
                    u32x2 o; o.x = pk2(v0, v1); o.y = pk2(v2, v3); *(LAS u32x2*)(vnT + dv * 72 + tk) = o; \
                    o.x = pk2(v0 * e0, v1 * e1); o.y = pk2(v2 * e2, v3 * e3); *(LAS u32x2*)(vn2T + dv * 72 + tk) = o; } } \
            lds_barrier();                                                                \
              \
            bf16x8 bq[4], ba[2], vn[2][2], ak[2], v2f[4][2]; \
            _Pragma("unroll") for (int ks = 0; ks < 4; ++ks) bq[ks] = lds_frag(ql, 136, trt * 16, ks * 32, F.lane); \
            _Pragma("unroll") for (int ks = 0; ks < 2; ++ks) { ba[ks] = lds_frag(ail, 72, trt * 16, ks * 32, F.lane); vn[0][ks] = lds_frag(vnT, 72, tc0 * 16, ks * 32, F.lane); vn[1][ks] = lds_frag(vnT, 72, tc0 * 16 + 16, ks * 32, F.lane); \
                ak[ks] = lds_frag(kTl, 72, F.wave * 16, ks * 32, F.lane); \
                _Pragma("unroll") for (int tc = 0; tc < 4; ++tc) v2f[tc][ks] = lds_frag(vn2T, 72, tc * 16, ks * 32, F.lane); } \
            __builtin_amdgcn_sched_barrier(0); \
              \
            {   bf16_t* Og = (bf16_t*)(F.ws + SC_O) + ((size_t)d * NR + row0 + trt * 16 + l15) * D + h * HD + half * 64; \
                f32x4 a0 = {0.f, 0.f, 0.f, 0.f}, a1 = {0.f, 0.f, 0.f, 0.f}; \
                _Pragma("unroll") for (int ks = 0; ks < 4; ++ks) { a0 = MFMA16(bs[0][ks], bq[ks], a0); a1 = MFMA16(bs[1][ks], bq[ks], a1); } \
                a0 = a0 * eg; a1 = a1 * eg; \
                _Pragma("unroll") for (int ks = 0; ks < 2; ++ks) { a0 = MFMA16(vn[0][ks], ba[ks], a0); a1 = MFMA16(vn[1][ks], ba[ks], a1); } \
                if (F8O) { unsigned char* Og8 = F.ws + SC_O + ((size_t)d * NR + row0 + trt * 16 + l15) * D + h * HD + half * 64; a0 = a0 * (float)(1 << F8_SO); a1 = a1 * (float)(1 << F8_SO); \
                    *(unsigned*)(Og8 + tc0 * 16 + 4 * quad) = pk4f8(a0[0], a0[1], a0[2], a0[3]); *(unsigned*)(Og8 + tc0 * 16 + 16 + 4 * quad) = pk4f8(a1[0], a1[1], a1[2], a1[3]); } \
                else { u32x2 o; o.x = pk2(a0[0], a0[1]); o.y = pk2(a0[2], a0[3]); *(u32x2*)(Og + tc0 * 16 + 4 * quad) = o; \
                o.x = pk2(a1[0], a1[1]); o.y = pk2(a1[2], a1[3]); *(u32x2*)(Og + tc0 * 16 + 16 + 4 * quad) = o; } } \
              \
            _Pragma("unroll") for (int tc = 0; tc < 4; ++tc) sacc[tc] = sacc[tc] * gS; \
            _Pragma("unroll") for (int ks = 0; ks < 2; ++ks) \
                _Pragma("unroll") for (int tc = 0; tc < 4; ++tc) sacc[tc] = MFMA16(ak[ks], v2f[tc][ks], sacc[tc]); \
            lds_barrier();                                                                \
            _Pragma("unroll") for (int tc = 0; tc < 4; ++tc) { u32x2 o; o.x = pk2(sacc[tc][0], sacc[tc][1]); o.y = pk2(sacc[tc][2], sacc[tc][3]); \
                *(LAS u32x2*)(St + (tc * 16 + l15) * 136 + F.wave * 16 + 4 * quad) = o; } } while (0)
        DNB_PREFETCH(R0, 0);
#pragma unroll 1
        for (int step = 0; step < NCH; ++step) { DNB_STEP(R0, step); }
        lds_barrier();
#undef DNB_CC
#undef DNB_PREFETCH
#undef DNB_STEP
    }
}
using pg8::Unit;
#ifndef WGM_
#define WGM_ 4
#endif
struct PlainSched {
    const char* A; const char* B; size_t a_bstride, b_bstride, a_tile, b_tile; int nM, nN, nbatch, G, c;
    DI bool next(int i, Unit& u) const {
        const int per = nM * nN; const long L = (long)i * G + c; if (L >= (long)per * nbatch) return false;
        const int bt = (int)(L / per); int wgid = (int)(L % per);
        { const int q = per / 8, r = per % 8, xcd = wgid % 8, off = wgid / 8; wgid = (xcd < r ? xcd * (q + 1) : r * (q + 1) + (xcd - r) * q) + off; }
        const int nig = WGM_ * nN, gid = wgid / nig, fm = gid * WGM_, gsz = (nM - fm) < WGM_ ? (nM - fm) : WGM_;
        u.pm = fm + ((wgid % nig) % gsz); u.pn = (wgid % nig) / gsz; u.aux = bt; u.aux2 = 0;
        u.A = A + (size_t)bt * a_bstride + (size_t)u.pm * a_tile; u.B = B + (size_t)bt * b_bstride + (size_t)u.pn * b_tile; return true;
    }
    DI int grow(const Unit&, int) const { return 0; }
};
struct WpSched { const char* Dt; const char* WB; int G, c, c0;
    DI bool next(int i, Unit& u) const {
        if (c < c0) return false;
        const long L = (long)i * (G - c0) + (c - c0); if (L >= 8 * 16) return false;
        const int bt = (int)(L >> 4), w = (int)(L & 15); u.pm = w & 1; u.pn = w >> 1; u.aux = bt; u.aux2 = 0;
        u.A = Dt + (size_t)u.pm * (256 * 512 * 2); u.B = WB + (size_t)(bt >> 2) * ((size_t)D * D * 2) + (size_t)(bt & 3) * (512 * 2) + (size_t)u.pn * ((size_t)256 * D * 2); return true; }
    DI int grow(const Unit&, int) const { return 0; } };
struct MoeSched {
    const LAS int* pre; const char* A; const char* B; size_t b_estride, a_tile, b_tile; const int* list; int nN, G, c; bool gather;
    DI bool next(int i, Unit& u) const {
        const int ntile = pre[16]; const long L = (long)i * G + c; if (L >= (long)ntile * nN) return false;
        const int rt = (int)(L / nN); u.pn = (int)(L % nN); int e = 0;
#pragma unroll
        for (int k = 1; k < NEXP; ++k) e += (rt >= pre[k]) ? 1 : 0;
        u.pm = rt; u.aux = e; u.aux2 = rt - pre[e];
        u.A = gather ? A : A + (size_t)rt * a_tile; u.B = B + (size_t)e * b_estride + (size_t)u.pn * b_tile; return true;
    }
    DI int grow(const Unit& u, int r) const { const int p = u.aux2 * 256 + r; return p < pre[32 + u.aux] ? list[(size_t)u.aux * LIST_CAP + p] : 0; }
};

#define EPI_LOOP_BF16(ADDR_EXPR) EPI_LOOP_BF16Q(ADDR_EXPR, 0)
#define EPI_LOOP_BF16Q(ADDR_EXPR, QQ) \
    _Pragma("unroll") for (int ai = 0; ai < 2; ++ai) _Pragma("unroll") for (int m = 0; m < 4; ++m) { const int r = ai * 128 + wr * 64 + m * 16 + fr; \
        _Pragma("unroll") for (int bj = 0; bj < 2; ++bj) { const int c8 = bj * 128 + wc * 32 + 8 * fq; f32x4 v0 = acc[ai][bj][m][0], v1 = acc[ai][bj][m][1]; if (QQ) { _Pragma("unroll") for (int z_ = 0; z_ < 4; ++z_) { v0[z_] = q8(v0[z_]); v1[z_] = q8(v1[z_]); } } \
            u32x4 w; w.x = pg8::cvt_pk_bf16(v0[0], v0[1]); w.y = pg8::cvt_pk_bf16(v0[2], v0[3]); w.z = pg8::cvt_pk_bf16(v1[0], v1[1]); w.w = pg8::cvt_pk_bf16(v1[2], v1[3]); \
            bf16_t* dst_ = (ADDR_EXPR); if (dst_) *(u32x4*)dst_ = w; } }

#define EPI_LOOP_F8(ADDR_EXPR, SC) \
    _Pragma("unroll") for (int ai = 0; ai < 2; ++ai) _Pragma("unroll") for (int m = 0; m < 4; ++m) { const int r = ai * 128 + wr * 64 + m * 16 + fr; \
        _Pragma("unroll") for (int bj = 0; bj < 2; ++bj) { const int c8 = bj * 128 + wc * 32 + 8 * fq; const f32x4 v0 = acc[ai][bj][m][0] * (SC), v1 = acc[ai][bj][m][1] * (SC); \
            u32x2 w; w.x = pk4f8(v0[0], v0[1], v0[2], v0[3]); w.y = pk4f8(v1[0], v1[1], v1[2], v1[3]); \
            unsigned char* dst_ = (ADDR_EXPR); if (dst_) *(u32x2*)dst_ = w; } }

struct EpiP { static constexpr bool PERM = true; bf16_t* P; float* AB;
    DI void operator()(const f32x4 (&acc)[2][2][4][2], const Unit& u, int wr, int wc, int fr, int fq) const {
        if (u.pn < 32) { EPI_LOOP_BF16(P + (size_t)(u.pm * 256 + r) * 8192 + u.pn * 256 + c8) }
        else {
#pragma unroll
            for (int ai = 0; ai < 2; ++ai)
#pragma unroll
                for (int m = 0; m < 4; ++m) { const int r = ai * 128 + wr * 64 + m * 16 + fr; const int c8 = wc * 32 + 8 * fq;
                    if (c8 < 64) { float* d = AB + (size_t)(u.pm * 256 + r) * 64 + c8; *(f32x4*)d = acc[ai][0][m][0]; *(f32x4*)(d + 4) = acc[ai][0][m][1]; } }
        }
    } };
struct EpiRes { static constexpr bool PERM = true; bf16_t* XS; const float* gate_base;
    DI void operator()(const f32x4 (&acc)[2][2][4][2], const Unit& u, int wr, int wc, int fr, int fq) const {
        const int mr = u.pm < 64 ? (u.pm >> 4) : 4; const float* g = gate_base + (size_t)mr * (NMOD * D) + u.pn * 256;
#pragma unroll
        for (int bj = 0; bj < 2; ++bj) { const int c8 = bj * 128 + wc * 32 + 8 * fq; const f32x4 g0 = *(const f32x4*)(g + c8), g1 = *(const f32x4*)(g + c8 + 4);
#pragma unroll
            for (int ai = 0; ai < 2; ++ai)
#pragma unroll
                for (int m = 0; m < 4; ++m) { const int r = ai * 128 + wr * 64 + m * 16 + fr; bf16_t* row = XS + (size_t)(u.pm * 256 + r) * D + u.pn * 256;
                    const u32x4 xr = *(const u32x4*)(row + c8);
                    f32x4 x0 = {__uint_as_float(xr.x << 16), __uint_as_float(xr.x & 0xffff0000u), __uint_as_float(xr.y << 16), __uint_as_float(xr.y & 0xffff0000u)};
                    f32x4 x1 = {__uint_as_float(xr.z << 16), __uint_as_float(xr.z & 0xffff0000u), __uint_as_float(xr.w << 16), __uint_as_float(xr.w & 0xffff0000u)};
                    x0 += g0 * acc[ai][bj][m][0]; x1 += g1 * acc[ai][bj][m][1];
                    u32x4 w; w.x = pg8::cvt_pk_bf16(x0[0], x0[1]); w.y = pg8::cvt_pk_bf16(x0[2], x0[3]); w.z = pg8::cvt_pk_bf16(x1[0], x1[1]); w.w = pg8::cvt_pk_bf16(x1[2], x1[3]);
                    *(u32x4*)(row + c8) = w;
                    if (m & 1) asm volatile("" ::: "memory"); } }
    } };
struct EpiWp { static constexpr bool PERM = true; bf16_t* WpT;
    DI void operator()(const f32x4 (&acc)[2][2][4][2], const Unit& u, int wr, int wc, int fr, int fq) const {
#if F8FN
        EPI_LOOP_F8((unsigned char*)WpT + (size_t)(u.aux * 512 + u.pm * 256 + r) * D + u.pn * 256 + c8, (float)(1 << F8_SWP)) } };
#else
        EPI_LOOP_BF16Q(WpT + (size_t)(u.aux * 512 + u.pm * 256 + r) * D + u.pn * 256 + c8, 1) } };
#endif
struct EpiYt { static constexpr bool PERM = true; bf16_t* Yt; bf16_t* YtC; bf16_t* YN; bf16_t* YNc;
    DI void operator()(const f32x4 (&acc)[2][2][4][2], const Unit& u, int wr, int wc, int fr, int fq) const {
        const int n0 = u.pm * 256, g = u.pm >> 1; const bool nyq = (u.pm & 1) && wr == 0 && fr == 0;
        if (u.pn < 64) { const int b = u.pn >> 4, half = (u.pn >> 3) & 1, t0 = (u.pn & 7) * 256;
#if F8FN
            EPI_LOOP_F8((unsigned char*)Yt + ((size_t)(b * D + n0 + r) * 4096) + half * 2048 + t0 + c8, (float)(1 << F8_SYT))
            if (nyq) {
#pragma unroll
                for (int bj = 0; bj < 2; ++bj) { const int c8 = bj * 128 + wc * 32 + 8 * fq; const f32x4 v0 = acc[0][bj][0][0] * (float)(1 << F8_SYT), v1 = acc[0][bj][0][1] * (float)(1 << F8_SYT);
                    u32x2 w; w.x = pk4f8(v0[0], v0[1], v0[2], v0[3]); w.y = pk4f8(v1[0], v1[1], v1[2], v1[3]);
                    *(u32x2*)((unsigned char*)YN + (size_t)(b * 4 + g) * 4096 + half * 2048 + t0 + c8) = w; } } }
#else
            EPI_LOOP_BF16Q(Yt + ((size_t)(b * D + n0 + r) * 4096) + half * 2048 + t0 + c8, 1)
            if (nyq) {
#pragma unroll
                for (int bj = 0; bj < 2; ++bj) { const int c8 = bj * 128 + wc * 32 + 8 * fq; const f32x4 v0 = acc[0][bj][0][0], v1 = acc[0][bj][0][1];
                    u32x4 w; w.x = pg8::cvt_pk_bf16(q8(v0[0]), q8(v0[1])); w.y = pg8::cvt_pk_bf16(q8(v0[2]), q8(v0[3])); w.z = pg8::cvt_pk_bf16(q8(v1[0]), q8(v1[1])); w.w = pg8::cvt_pk_bf16(q8(v1[2]), q8(v1[3]));
                    *(u32x4*)(YN + (size_t)(b * 4 + g) * 4096 + half * 2048 + t0 + c8) = w; } } }
#endif
        else { const int b = u.pn - 64;
            EPI_LOOP_BF16Q(YtC + ((size_t)(b * D + n0 + r) * 256) + c8, 0)
            if (nyq) {
#pragma unroll
                for (int bj = 0; bj < 2; ++bj) { const int c8 = bj * 128 + wc * 32 + 8 * fq; const f32x4 v0 = acc[0][bj][0][0], v1 = acc[0][bj][0][1];
                    u32x4 w; w.x = pg8::cvt_pk_bf16(v0[0], v0[1]); w.y = pg8::cvt_pk_bf16(v0[2], v0[3]); w.z = pg8::cvt_pk_bf16(v1[0], v1[1]); w.w = pg8::cvt_pk_bf16(v1[2], v1[3]);
                    *(u32x4*)(YNc + (size_t)(b * 4 + g) * 256 + c8) = w; } } }
    } };
struct EpiMixP { static constexpr bool PERM = true; bf16_t* O; int row0, bshift, bstride, rstride, pmask;
    DI void operator()(const f32x4 (&acc)[2][2][4][2], const Unit& u, int wr, int wc, int fr, int fq) const {
        const bool sine = u.pn & 1;
#pragma unroll
        for (int ai = 0; ai < 2; ++ai)
#pragma unroll
            for (int m = 0; m < 4; ++m) { const int r = ai * 128 + wr * 64 + m * 16 + fr; bf16_t* rowp = O + (size_t)(row0 + (u.aux >> bshift) * bstride + rstride * (u.pm * 256 + r) + (u.aux & pmask)) * D + u.pn * 256;
#pragma unroll
                for (int bj = 0; bj < 2; ++bj) { const int c8 = bj * 128 + wc * 32 + 8 * fq; f32x4 v0 = acc[ai][bj][m][0], v1 = acc[ai][bj][m][1];
#pragma unroll
                    for (int z_ = 0; z_ < 4; ++z_) { v0[z_] = q8(v0[z_]); v1[z_] = q8(v1[z_]); }
#if F8G2F
                    const float s8 = (float)(1 << F8_SY); unsigned char* rp8 = (unsigned char*)O + (size_t)(rowp - O);
                    u32x2 w; w.x = pk4f8(v0[0] * s8, v0[1] * s8, v0[2] * s8, v0[3] * s8); w.y = pk4f8(v1[0] * s8, v1[1] * s8, v1[2] * s8, v1[3] * s8);
                    if (sine && c8 == 0) { rp8[1] = (unsigned char)(w.x >> 8); *(unsigned short*)(rp8 + 2) = (unsigned short)(w.x >> 16); *(unsigned*)(rp8 + 4) = w.y; }
                    else *(u32x2*)(rp8 + c8) = w; } }
#else
                    u32x4 w; w.x = pg8::cvt_pk_bf16(v0[0], v0[1]); w.y = pg8::cvt_pk_bf16(v0[2], v0[3]); w.z = pg8::cvt_pk_bf16(v1[0], v1[1]); w.w = pg8::cvt_pk_bf16(v1[2], v1[3]);
                    if (sine && c8 == 0) { *(bf16_t*)(rowp + 1) = (bf16_t)(w.x >> 16); *(unsigned*)(rowp + 2) = w.y; *(u32x2*)(rowp + 4) = (u32x2){w.z, w.w}; }
                    else *(u32x4*)(rowp + c8) = w; } }
#endif
    } };
struct EpiMixS { static constexpr bool PERM = true; bf16_t* O;
    DI void operator()(const f32x4 (&acc)[2][2][4][2], const Unit& u, int wr, int wc, int fr, int fq) const {
        const bool sine = u.pn & 1; const int b = u.aux >> 1, par = u.aux & 1;
#pragma unroll
        for (int ai = 0; ai < 2; ++ai)
#pragma unroll
            for (int m = 0; m < 4; ++m) { const int r = ai * 128 + wr * 64 + m * 16 + fr; const int k = 2 * (u.pm * 256 + r) + par;
                bf16_t* row1 = O + (size_t)(b * SEQ + k) * D + u.pn * 256; bf16_t* row2 = O + (size_t)(b * SEQ + SEQ - k) * D + u.pn * 256;
#pragma unroll
                for (int bj = 0; bj < 2; ++bj) { const int c8 = bj * 128 + wc * 32 + 8 * fq; f32x4 v0 = acc[ai][bj][m][0], v1 = acc[ai][bj][m][1];
#pragma unroll
                    for (int z_ = 0; z_ < 4; ++z_) { v0[z_] = q8(v0[z_]); v1[z_] = q8(v1[z_]); }
#if F8G2F
                    const float s8 = (float)(1 << F8_SY); unsigned char* r1 = (unsigned char*)O + (size_t)(row1 - O); unsigned char* r2 = (unsigned char*)O + (size_t)(row2 - O);
                    u32x2 w; w.x = pk4f8(v0[0] * s8, v0[1] * s8, v0[2] * s8, v0[3] * s8); w.y = pk4f8(v1[0] * s8, v1[1] * s8, v1[2] * s8, v1[3] * s8);
                    u32x2 wm = w; if (sine) { wm.x ^= 0x80808080u; wm.y ^= 0x80808080u; }
                    if (sine && c8 == 0) { r1[1] = (unsigned char)(w.x >> 8); *(unsigned short*)(r1 + 2) = (unsigned short)(w.x >> 16); *(unsigned*)(r1 + 4) = w.y;
                        if (k != 0) { r2[1] = (unsigned char)(wm.x >> 8); *(unsigned short*)(r2 + 2) = (unsigned short)(wm.x >> 16); *(unsigned*)(r2 + 4) = wm.y; } }
                    else { *(u32x2*)(r1 + c8) = w; if (k != 0) *(u32x2*)(r2 + c8) = wm; } } }
#else
                    u32x4 w; w.x = pg8::cvt_pk_bf16(v0[0], v0[1]); w.y = pg8::cvt_pk_bf16(v0[2], v0[3]); w.z = pg8::cvt_pk_bf16(v1[0], v1[1]); w.w = pg8::cvt_pk_bf16(v1[2], v1[3]);
                    u32x4 wm = w; if (sine) { wm.x ^= 0x80008000u; wm.y ^= 0x80008000u; wm.z ^= 0x80008000u; wm.w ^= 0x80008000u; }
                    if (sine && c8 == 0) { *(bf16_t*)(row1 + 1) = (bf16_t)(w.x >> 16); *(unsigned*)(row1 + 2) = w.y; *(u32x2*)(row1 + 4) = (u32x2){w.z, w.w};
                        if (k != 0) { *(bf16_t*)(row2 + 1) = (bf16_t)(wm.x >> 16); *(unsigned*)(row2 + 2) = wm.y; *(u32x2*)(row2 + 4) = (u32x2){wm.z, wm.w}; } }
                    else { *(u32x4*)(row1 + c8) = w; if (k != 0) *(u32x4*)(row2 + c8) = wm; } } }
#endif
    } };
struct F2Sched { const char* CT; const char* Yt; int G, c;
    DI bool next(int i, Unit& u) const {
        const long L = (long)i * G + c; if (L >= 8 * 32) return false;
        const int bt = (int)(L >> 5), w = (int)(L & 31); u.pm = w & 3; u.pn = w >> 2; u.aux = bt; u.aux2 = 0;
        constexpr size_t EB = F8FN ? 1 : 2;
        u.A = CT + (size_t)((u.pn & 1) * 2 + (bt & 1)) * ((size_t)2048 * 2048 * EB) + (size_t)u.pm * ((size_t)256 * 2048 * EB);
        u.B = Yt + (size_t)(bt >> 1) * ((size_t)D * 4096 * EB) + (size_t)(bt & 1) * (2048 * EB) + (size_t)u.pn * ((size_t)256 * 4096 * EB); return true; }
    DI int grow(const Unit&, int) const { return 0; } };
struct F2cSched { const char* CT2; const char* YtC; int G, c;
    DI bool next(int i, Unit& u) const {
        const long L = (long)i * G + c; if (L >= 32) return false;
        u.pm = 0; u.pn = (int)(L & 7); u.aux = (int)(L >> 3); u.aux2 = 0;
        u.A = CT2 + (size_t)(u.pn & 1) * (256 * 256 * 2); u.B = YtC + (size_t)u.aux * ((size_t)D * 256 * 2) + (size_t)u.pn * (256 * 256 * 2); return true; }
    DI int grow(const Unit&, int) const { return 0; } };
#if F8G2F
#define OUT1(idx, val) ((unsigned char*)O)[idx] = f2f8((val) * (float)(1 << F8_SY))
#else
#define OUT1(idx, val) O[idx] = f2bf(val)
#endif
DI void nyq_fix(const Frame& F, bool with_ctx) {
    LAS float* red = (LAS float*)F.lds;
    const int quad = F.lane >> 4, l15 = F.lane & 15;
    bf16_t* O = (bf16_t*)(F.ws + WS_HB);
#if F8FN
    const unsigned char* CT = F.ws + WS_CT; const unsigned char* YN = F.ws + SC_YN;
    for (int i = F.bid; i < 256; i += F.G) { const int par = i >> 7, m0 = (i & 127) * 16;
        const unsigned char* Ap = CT + (size_t)par * 2048 * 2048 + (size_t)(m0 + l15) * 2048 + quad * 8; const unsigned char* Bp = YN + (size_t)l15 * 4096 + par * 2048 + quad * 8;
        f32x4 acc = {0.f, 0.f, 0.f, 0.f};
#pragma unroll
        for (int ks = 0; ks < 8; ++ks) { const int k0 = (F.wave * 8 + ks) * 32; acc = __builtin_amdgcn_mfma_f32_16x16x32_fp8_fp8(*(const long*)(Ap + k0), *(const long*)(Bp + k0), acc, 0, 0, 0); }
        acc = acc * (1.0f / (float)(1 << (F8_SCT + F8_SYT)));
#else
    const bf16_t* CT = (const bf16_t*)(F.ws + WS_CT); const bf16_t* YN = (const bf16_t*)(F.ws + SC_YN);
    for (int i = F.bid; i < 256; i += F.G) { const int par = i >> 7, m0 = (i & 127) * 16;
        const bf16_t* Ap = CT + (size_t)par * 2048 * 2048 + (size_t)(m0 + l15) * 2048 + quad * 8; const bf16_t* Bp = YN + (size_t)l15 * 4096 + par * 2048 + quad * 8;
        f32x4 acc = {0.f, 0.f, 0.f, 0.f};
#pragma unroll
        for (int ks = 0; ks < 8; ++ks) { const int k0 = (F.wave * 8 + ks) * 32; acc = MFMA16(*(const bf16x8*)(Ap + k0), *(const bf16x8*)(Bp + k0), acc); }
#endif
        *(LAS f32x4*)(red + (F.wave * 64 + F.lane) * 4) = acc;
        __syncthreads();
        if (F.wave == 0) { f32x4 s = {0.f, 0.f, 0.f, 0.f};
#pragma unroll
            for (int w = 0; w < 8; ++w) s += *(const LAS f32x4*)(red + (w * 64 + F.lane) * 4);
            const int b = l15 >> 2, g = l15 & 3;
#pragma unroll
            for (int jj = 0; jj < 4; ++jj) OUT1((size_t)(b * SEQ + 2 * (m0 + 4 * quad + jj) + par) * D + g * 512 + 256, s[jj]); }
        __syncthreads();
    }
#if F8FN
    {   const unsigned char* Yt = F.ws + SC_YT;
        for (int q = F.bid * 8 + F.wave; q < NB * D; q += F.G * 8) { const int b = q >> 11, n = q & 2047, jr = n & 511;
            if (jr == 256) continue;
            float sres = 0.f;
            if (jr < 256) { const unsigned char* yp = Yt + ((size_t)(b * D + n)) * 4096 + F.lane * 32; float sa = 0.f;
#pragma unroll
                for (int i = 0; i < 2; ++i) { const u32x4 w = *(const u32x4*)(yp + i * 16);
#pragma unroll
                    for (int q4 = 0; q4 < 4; ++q4) { const f32x4 f = unpk4f8(w[q4]); sa += (f[0] - f[1]) + (f[2] - f[3]); } }
                sres = wave_sum(sa) * (1.0f / (64.0f * (float)(1 << F8_SYT))); }
            if (F.lane == 0) OUT1((size_t)(b * SEQ + 2048) * D + n, sres); } }
#else
    {   const bf16_t* Yt = (const bf16_t*)(F.ws + SC_YT);
        for (int q = F.bid * 8 + F.wave; q < NB * D; q += F.G * 8) { const int b = q >> 11, n = q & 2047, jr = n & 511;
            if (jr == 256) continue;
            float sres = 0.f;
            if (jr < 256) { const bf16_t* yp = Yt + ((size_t)(b * D + n)) * 4096 + F.lane * 32; float sa = 0.f;
#pragma unroll
                for (int i = 0; i < 4; ++i) { float f[8]; unpack8(*(const u32x4*)(yp + i * 8), f); sa += (f[0] - f[1]) + (f[2] - f[3]) + (f[4] - f[5]) + (f[6] - f[7]); }
                sres = wave_sum(sa) * (1.0f / 64.0f); }
            if (F.lane == 0) OUT1((size_t)(b * SEQ + 2048) * D + n, sres); } }
#endif
    if (with_ctx) { const bf16_t* CT2 = (const bf16_t*)(F.ws + WS_CT2); const bf16_t* YNc = (const bf16_t*)(F.ws + SC_YNC);
        for (int i = F.bid; i < 16; i += F.G) { const int m0 = i * 16;
            const bf16_t* Ap = CT2 + (size_t)(m0 + l15) * 256 + quad * 8; const bf16_t* Bp = YNc + (size_t)l15 * 256 + quad * 8;
            f32x4 acc = {0.f, 0.f, 0.f, 0.f};
            acc = MFMA16(*(const bf16x8*)(Ap + F.wave * 32), *(const bf16x8*)(Bp + F.wave * 32), acc);
            *(LAS f32x4*)(red + (F.wave * 64 + F.lane) * 4) = acc;
            __syncthreads();
            if (F.wave == 0) { f32x4 s = {0.f, 0.f, 0.f, 0.f};
#pragma unroll
                for (int w = 0; w < 8; ++w) s += *(const LAS f32x4*)(red + (w * 64 + F.lane) * 4);
                const int b = l15 >> 2, g = l15 & 3;
#pragma unroll
                for (int jj = 0; jj < 4; ++jj) OUT1((size_t)(NLAT + b * CTXL + m0 + 4 * quad + jj) * D + g * 512 + 256, s[jj]); }
            __syncthreads();
        } }
}
struct EpiAct { static constexpr bool PERM = true; unsigned char* ACT;
    DI void operator()(const f32x4 (&acc)[2][2][4][2], const Unit& u, int wr, int wc, int fr, int fq) const {
#pragma unroll
        for (int ai = 0; ai < 2; ++ai)
#pragma unroll
            for (int m = 0; m < 4; ++m) { const int r = ai * 128 + wr * 64 + m * 16 + fr; const int c8 = wc * 32 + 8 * fq; float o[8];
#pragma unroll
                for (int n = 0; n < 2; ++n)
#pragma unroll
                    for (int k = 0; k < 4; ++k) o[n * 4 + k] = siluf(acc[ai][0][m][n][k]) * acc[ai][1][m][n][k] * (float)(1 << F8_SACT);
                u32x2 w; w.x = pk4f8(o[0], o[1], o[2], o[3]); w.y = pk4f8(o[4], o[5], o[6], o[7]);
                *(u32x2*)(ACT + (size_t)(u.pm * 256 + r) * DFF + u.pn * 128 + c8) = w; }
    } };
struct EpiYe { static constexpr bool PERM = true; bf16_t* YE;
    DI void operator()(const f32x4 (&acc)[2][2][4][2], const Unit& u, int wr, int wc, int fr, int fq) const {
#if F8YE
        unsigned char* Y8 = (unsigned char*)YE; const float s = (float)(1 << F8_SYE);
#pragma unroll
        for (int ai = 0; ai < 2; ++ai)
#pragma unroll
            for (int m = 0; m < 4; ++m) { const int r = ai * 128 + wr * 64 + m * 16 + fr;
#pragma unroll
                for (int bj = 0; bj < 2; ++bj) { const int c8 = bj * 128 + wc * 32 + 8 * fq; const f32x4 v0 = acc[ai][bj][m][0] * s, v1 = acc[ai][bj][m][1] * s;
                    u32x2 w; w.x = pk4f8(v0[0], v0[1], v0[2], v0[3]); w.y = pk4f8(v1[0], v1[1], v1[2], v1[3]);
                    *(u32x2*)(Y8 + (size_t)(u.pm * 256 + r) * D + u.pn * 256 + c8) = w; } }
#else
        EPI_LOOP_BF16(YE + (size_t)(u.pm * 256 + r) * D + u.pn * 256 + c8)
#endif
    } };
#ifndef EN
#define EN 0x1FFFF
#endif
#ifndef REP
#define REP 0
#endif
struct Args { const float* in[22]; float* out; unsigned char* ws; int ph_lo, ph_hi; };
constexpr int LDS_BYTES = 155648;
constexpr int N_PHASES = 34;

__global__ void __launch_bounds__(NT, 2) __attribute__((amdgpu_waves_per_eu(2, 2))) fwd_kernel(Args args) {
    extern __shared__ __attribute__((aligned(16))) unsigned char lds_raw[];
    Frame F;
    F.lds = (LAS unsigned char*)lds_raw; F.tid = threadIdx.x; F.lane = F.tid & 63; F.wave = __builtin_amdgcn_readfirstlane(F.tid >> 6); F.G = gridDim.x; F.bid = blockIdx.x;
    F.in = (intab_t)__builtin_amdgcn_kernarg_segment_ptr();
    F.out = args.out; F.ws = args.ws; F.ctl = (unsigned*)(args.ws + WS_CTL);
    volatile LAS unsigned* xbw = (volatile LAS unsigned*)(F.lds + LDS_BYTES - 16);
    if (F.tid < 4) xbw[F.tid] = 0u;
    __syncthreads();
    const int lo = args.ph_lo, hi = args.ph_hi;
    XcdBarrier bar; bar.bar = F.ctl + CW_BAR; bar.x = 0; bar.st = xbw;
    if (hi - lo > 1) bar = xcd_barrier_post(F.ctl + CW_BAR, xbw);
    int pc = 0;
#define PHASE_BEGIN { const bool run_ = (pc >= lo && pc < hi); if (run_) { { int t_ = threadIdx.x; GAS unsigned char* w_ = (GAS unsigned char*)args.ws; intab_t k_ = (intab_t)__builtin_amdgcn_kernarg_segment_ptr(); asm volatile("" : "+v"(t_), "+s"(w_), "+s"(k_)); F.tid = t_; F.lane = t_ & 63; F.ws = (unsigned char*)w_; F.in = k_; F.ctl = (unsigned*)(w_ + WS_CTL); F.out = (float*)(GAS float*)args.out; }
#define PHASE_END } if (run_ && pc + 1 < hi) xcd_barrier(bar); ++pc; }
    LAS unsigned char* glds = F.lds;

#ifndef XBAR
#define XBAR 0
#endif
    if (XBAR) { for (int q_ = 0; q_ < 36; ++q_) xcd_barrier(bar); }
    PHASE_BEGIN
#if EN & 1
phase_mod(F);
#if REP & 1
__syncthreads(); phase_mod(F);
#endif
#endif
 PHASE_END

#pragma unroll 1
    for (int layer = 0; layer < DEPTH; ++layer) {
        const bool dn = (layer & 1) == 0; const int j = layer >> 1;
        const int nrows = layer < DEPTH - 1 ? NR : NLAT;
        const int nMr = nrows / 256;
        const int nrows2 = layer >= 2 ? NLAT : nrows, nMr2 = nrows2 / 256;
        PHASE_BEGIN
#if EN & 2
phase_cvt(F, layer);
#if REP & 2
__syncthreads(); phase_cvt(F, layer);
#endif
#endif

#if EN & 4
phase_thin_a(F, layer, nrows, !dn);
#if REP & 4
__syncthreads(); phase_thin_a(F, layer, nrows, !dn);
#endif
#endif
 PHASE_END
        if (dn) {
            PHASE_BEGIN {
#if F8G1
                PlainSched S{(const char*)(F.ws + WS_HB), (const char*)(F.ws + WM_IN), 0, 0, (size_t)256 * D, (size_t)256 * D, nMr, DN_INP / 256, 1, F.G, F.bid};
#define G1DN_ARGS false, 127 - F8_SH - F8_SWIN>(glds, F.tid, D / 2, D / 2, D / 2, S, E)
#else
                PlainSched S{(const char*)(F.ws + WS_HB), (const char*)(F.ws + WM_IN), 0, 0, (size_t)256 * D * 2, (size_t)256 * D * 2, nMr, DN_INP / 256, 1, F.G, F.bid};
#define G1DN_ARGS false>(glds, F.tid, D, D, D, S, E)
#endif
                EpiP E{(bf16_t*)(F.ws + SC_P), (float*)(F.ws + SC_AB)};

#if EN & 256
pg8::gemm_phase<EpiP, PlainSched, G1DN_ARGS;
#if REP & 256
__syncthreads(); pg8::gemm_phase<EpiP, PlainSched, G1DN_ARGS;
#endif
#endif
                if (layer == 0) {
                    { int t_ = F.tid; asm volatile("" : "+v"(t_)); F.tid = t_; F.lane = t_ & 63; }
                    const int per_ = nMr * (DN_INP / 256), c0_ = per_ % F.G;
                    WpSched S2{(const char*)(F.ws + WS_DT), (const char*)(F.ws + WS_WB2), F.G, F.bid, c0_};
                    EpiWp E2{(bf16_t*)(F.ws + WS_WP2)};
                    int kw_ = 512; asm volatile("" : "+s"(kw_));
#if EN & 512
                    pg8::gemm_phase<EpiWp, WpSched, false>(glds, F.tid, kw_, kw_, D, S2, E2);
#endif
                }
 } PHASE_END
            PHASE_BEGIN
#if EN & 8
phase_dn_a(F, j);
#if REP & 8
__syncthreads(); phase_dn_a(F, j);
#endif
#endif
 PHASE_END
            PHASE_BEGIN
#if EN & 16
phase_dn_b(F, j);
#if REP & 16
__syncthreads(); phase_dn_b(F, j);
#endif
#endif
 PHASE_END
            PHASE_BEGIN
#if EN & 32
phase_dn_out(F, j, nrows2);
#if REP & 32
__syncthreads(); phase_dn_out(F, j, nrows2);
#endif
#endif
 PHASE_END
        } else {
            PHASE_BEGIN {
#if F8FN
                PlainSched S{(const char*)(F.ws + WS_WP2) + (size_t)j * ((size_t)D * D), (const char*)(F.ws + WS_HB), 0, 0, (size_t)256 * D, (size_t)256 * D, 8, nMr, 1, F.G, F.bid};
#define G1FN_ARGS false, 127 - F8_SWP - F8_SH>(glds, F.tid, D / 2, D / 2, D / 2, S, E)
#define F2_ARGS false, 127 - F8_SCT - F8_SYT>(glds, F.tid, 1024, 1024, 2048, S, E)
#else
                PlainSched S{(const char*)(F.ws + WS_WP2) + (size_t)j * ((size_t)D * D * 2), (const char*)(F.ws + WS_HB), 0, 0, (size_t)256 * D * 2, (size_t)256 * D * 2, 8, nMr, 1, F.G, F.bid};
#define G1FN_ARGS false>(glds, F.tid, D, D, D, S, E)
#define F2_ARGS false>(glds, F.tid, 2048, 2048, 4096, S, E)
#endif
                EpiYt E{(bf16_t*)(F.ws + SC_YT), (bf16_t*)(F.ws + SC_YTC), (bf16_t*)(F.ws + SC_YN), (bf16_t*)(F.ws + SC_YNC)};
#if EN & 1024
                pg8::gemm_phase<EpiYt, PlainSched, G1FN_ARGS;
#if REP & 1024
                __syncthreads(); pg8::gemm_phase<EpiYt, PlainSched, G1FN_ARGS;
#endif
#endif
            } PHASE_END
            PHASE_BEGIN {
                {   F2Sched S{(const char*)(F.ws + WS_CT), (const char*)(F.ws + SC_YT), F.G, F.bid};
                    EpiMixS E{(bf16_t*)(F.ws + WS_HB)};
#if EN & 2048
                    pg8::gemm_phase<EpiMixS, F2Sched, F2_ARGS;
#if REP & 2048
                    __syncthreads(); pg8::gemm_phase<EpiMixS, F2Sched, F2_ARGS;
#endif
#endif
                }
                if (nrows > NLAT) {
                    F2cSched S{(const char*)(F.ws + WS_CT2), (const char*)(F.ws + SC_YTC), F.G, F.bid};
                    EpiMixP E{(bf16_t*)(F.ws + WS_HB), NLAT, 0, CTXL, 1, 0};
#if EN & 4096
                    int kc_ = 256; asm volatile("" : "+s"(kc_));
                    pg8::gemm_phase<EpiMixP, F2cSched, false>(glds, F.tid, kc_, kc_, kc_, S, E);
#endif
                }
#if EN & 2048
                nyq_fix(F, nrows > NLAT);
#endif
            } PHASE_END
        }
        PHASE_BEGIN {
            EpiRes E{(bf16_t*)(F.ws + WS_XS), modp(F, layer, 0, 2)};
#if EN & 8192
            if (F8G2 && (dn || F8G2F)) {
                PlainSched S{(const char*)(F.ws + WS_HB), (const char*)(F.ws + WM_OUT), 0, 0, (size_t)256 * D, (size_t)256 * D, nMr2, 8, 1, F.G, F.bid};
                pg8::gemm_phase<EpiRes, PlainSched, false, 127 - F8_SY - F8_SWOUT>(glds, F.tid, D / 2, D / 2, D / 2, S, E);
            } else {
                PlainSched S{(const char*)(F.ws + WS_HB), (const char*)(F.ws + WM_OUT), 0, 0, (size_t)256 * D * 2, (size_t)256 * D * 2, nMr2, 8, 1, F.G, F.bid};
                pg8::gemm_phase<EpiRes, PlainSched, false>(glds, F.tid, D, D, D, S, E);
            }
#endif
 } PHASE_END
        PHASE_BEGIN
#if EN & 64
phase_thin_b(F, layer, nrows2);
#if REP & 64
__syncthreads(); phase_thin_b(F, layer, nrows2);
#endif
#endif
 PHASE_END
        PHASE_BEGIN {
            moe_prefix_to_lds(F, layer);
            MoeSched S{(const LAS int*)(F.lds + MISC_OFF), (const char*)(F.ws + WS_HB), (const char*)(F.ws + WS_WGU), (size_t)1024 * D, 0, (size_t)256 * D, (const int*)(F.ws + WS_LIST), 4, F.G, F.bid, true};
            EpiAct E{F.ws + WS_ACT};

#if EN & 16384
pg8::gemm_phase<EpiAct, MoeSched, true, 127 - F8_SH - F8_SWGU>(glds, F.tid, D / 2, D / 2, D / 2, S, E);
#if REP & 16384
__syncthreads(); pg8::gemm_phase<EpiAct, MoeSched, true, 127 - F8_SH - F8_SWGU>(glds, F.tid, D / 2, D / 2, D / 2, S, E);
#endif
#endif
 } PHASE_END
        PHASE_BEGIN {
            moe_prefix_to_lds(F, layer);
            MoeSched S{(const LAS int*)(F.lds + MISC_OFF), (const char*)(F.ws + WS_ACT), (const char*)(F.ws + WS_WD), (size_t)D * DFF, (size_t)256 * DFF, (size_t)256 * DFF, (const int*)(F.ws + WS_LIST), 8, F.G, F.bid, false};
            EpiYe E{(bf16_t*)(F.ws + WS_YE)};
            int kd_ = DFF / 2; asm volatile("" : "+s"(kd_));

#if EN & 32768
pg8::gemm_phase<EpiYe, MoeSched, false, 127 - F8_SACT - F8_SWD>(glds, F.tid, kd_, DFF / 2, DFF / 2, S, E);
#if REP & 32768
__syncthreads(); pg8::gemm_phase<EpiYe, MoeSched, false, 127 - F8_SACT - F8_SWD>(glds, F.tid, kd_, DFF / 2, DFF / 2, S, E);
#endif
#endif
 } PHASE_END
    }
    PHASE_BEGIN
#if EN & 128
phase_final(F);
#if REP & 128
__syncthreads(); phase_final(F);
#endif
#endif
 PHASE_END
#undef PHASE_BEGIN
#undef PHASE_END
}

extern "C" void kernel_launch(void* const* d_in, const int* in_sizes, int n_in, void* d_out, int out_size, void* d_ws, size_t ws_size, hipStream_t stream) {
    static int grid = 0;
    if (grid == 0) {
        if (n_in != 22 || out_size != NLAT * D || ws_size < WS_END) { fprintf(stderr, "kernel_launch: unexpected shapes (n_in %d, out %d, ws %zu, need %zu)\n", n_in, out_size, ws_size, (size_t)WS_END); grid = -1; return; }
        int dev = 0, cus = 0, per_cu = 0;
        if (hipGetDevice(&dev) != hipSuccess || hipDeviceGetAttribute(&cus, hipDeviceAttributeMultiprocessorCount, dev) != hipSuccess) { grid = -1; return; }
        if (hipFuncSetAttribute((const void*)fwd_kernel, hipFuncAttributeMaxDynamicSharedMemorySize, LDS_BYTES) != hipSuccess) { fprintf(stderr, "kernel_launch: hipFuncSetAttribute failed\n"); grid = -1; return; }
        if (hipOccupancyMaxActiveBlocksPerMultiprocessor(&per_cu, (const void*)fwd_kernel, NT, LDS_BYTES) != hipSuccess || per_cu < 1) { fprintf(stderr, "kernel_launch: occupancy query says %d\n", per_cu); (void)hipGetLastError(); }
        grid = cus;
    }
    if (grid < 0) return;
    (void)hipMemsetAsync((char*)d_ws + WS_CTL, 0, CTL_BYTES, stream);
    Args a{};
    for (int i = 0; i < 22; ++i) a.in[i] = (const float*)d_in[i];
    a.out = (float*)d_out; a.ws = (unsigned char*)d_ws;
#if N_LAUNCH_MODE == 0
    a.ph_lo = 0; a.ph_hi = N_PHASES;
    hipLaunchKernelGGL(fwd_kernel, dim3(grid), dim3(NT), LDS_BYTES, stream, a);
#else
    for (int p = 0; p < N_PHASES; ++p) { a.ph_lo = p; a.ph_hi = p + 1; hipLaunchKernelGGL(fwd_kernel, dim3(grid), dim3(NT), LDS_BYTES, stream, a); }
#endif
}
```

```cpp
#include <hip/hip_runtime.h>
#include <cstdio>
#include <cstdint>

#ifndef N_LAUNCH_MODE
#define N_LAUNCH_MODE 0
#endif

#define F8G1 1
#define F8G2 1
#define F8G2F 1
#define F8FN 1
#define F8QK 1
#define F8O 1
#define F8YE 1
#define LAS __attribute__((address_space(3)))
typedef unsigned short bf16_t;
typedef short bf16x8 __attribute__((ext_vector_type(8)));
typedef float f32x4 __attribute__((ext_vector_type(4)));
typedef float f32x2 __attribute__((ext_vector_type(2)));
typedef unsigned u32x4 __attribute__((ext_vector_type(4)));
typedef unsigned u32x2 __attribute__((ext_vector_type(2)));
#define DI __device__ __forceinline__

constexpr int D = 2048, NB = 4, SEQ = 4096, CTXL = 256, DEPTH = 4;
constexpr int NLAT = NB * SEQ, NCTX = NB * CTXL, NR = NLAT + NCTX;
constexpr int HEADS = 16, HD = 128, DN_IN = 8256, DN_INP = 8448;
constexpr int NEXP = 16, DFF = 512, NMOD = 6;
constexpr int NCH = 68;
constexpr int NUNIT = NB * HEADS * NCH;
constexpr int SLOT_ROWS = 39168;
constexpr int LIST_CAP = NR;
constexpr float EPS = 1e-6f;
constexpr int NT = 512, NW = 8;

constexpr size_t AL(size_t x) { return (x + 255) & ~(size_t)255; }
constexpr size_t WS_CTL = 0;
constexpr size_t CTL_BYTES = 65536;
constexpr size_t WS_MOD = WS_CTL + CTL_BYTES;
constexpr size_t WS_DT = AL(WS_MOD + (size_t)DEPTH * 5 * NMOD * D * 4);
constexpr size_t WS_CT = AL(WS_DT + (size_t)1024 * 512 * 2);
constexpr size_t WS_CT2 = AL(WS_CT + (size_t)4096 * 8192 * 2);
constexpr size_t WS_RWP = WS_DT + (size_t)768 * 512 * 2;
constexpr size_t WS_XS = AL(WS_CT2 + (size_t)256 * 512 * 2);
constexpr size_t WS_HB = AL(WS_XS + (size_t)NR * D * 2);
constexpr size_t WS_WMIX = AL(WS_HB + (size_t)NR * D * 2);
constexpr size_t WMIX_BYTES = (size_t)DN_INP * D * 2 + (size_t)D * D * 2;
constexpr size_t WS_WGU = AL(WS_WMIX + WMIX_BYTES);
constexpr size_t WS_WD = AL(WS_WGU + (size_t)NEXP * 1024 * D * 2);
constexpr size_t WS_WB2 = AL(WS_WD + (size_t)NEXP * D * DFF * 2);
constexpr size_t WS_WP2 = AL(WS_WB2 + (size_t)2 * D * D * 2);
constexpr size_t WS_ROUTE = AL(WS_WP2 + (size_t)2 * D * D * 2);
constexpr size_t WS_LIST = AL(WS_ROUTE + (size_t)NR * 32);
constexpr size_t WS_ACT = AL(WS_LIST + (size_t)NEXP * LIST_CAP * 4);
constexpr size_t WS_YE = AL(WS_ACT + (size_t)SLOT_ROWS * DFF * 2);
constexpr size_t WS_SCR = AL(WS_YE + (size_t)SLOT_ROWS * D * 2);
constexpr size_t SC_P = WS_SCR;
constexpr size_t SC_AB = AL(SC_P + (size_t)NR * 8192 * 2);
constexpr size_t SC_QN = AL(SC_AB + (size_t)NR * 64 * 4);
constexpr size_t SC_KT = AL(SC_QN + (size_t)NUNIT * 64 * 128 * 2);
constexpr size_t SC_UT = AL(SC_KT + (size_t)NUNIT * 64 * 128 * 2);
constexpr size_t SC_W = AL(SC_UT + (size_t)2 * NUNIT * 64 * 128 * 2);
constexpr size_t SC_AI = AL(SC_W + (size_t)2 * NUNIT * 64 * 128 * 2);
constexpr size_t SC_G = AL(SC_AI + (size_t)2 * NUNIT * 64 * 64 * 2);
constexpr size_t SC_O = AL(SC_G + (size_t)2 * NUNIT * 64 * 4);
constexpr size_t SC_DN_END = AL(SC_O + (size_t)2 * NR * D * 2);
constexpr size_t SC_YT = WS_SCR;
constexpr size_t SC_YTC = AL(SC_YT + (size_t)NB * D * 4096 * 2);
constexpr size_t SC_YN = AL(SC_YTC + (size_t)NB * D * 256 * 2);
constexpr size_t SC_YNC = AL(SC_YN + (size_t)16 * 4096 * 2);
constexpr size_t SC_FN_END = AL(SC_YNC + (size_t)16 * 256 * 2);
constexpr size_t WS_END = SC_DN_END > SC_FN_END ? SC_DN_END : SC_FN_END;
static_assert(WS_END <= (size_t)1600 * 1000 * 1000, "workspace map too large");
constexpr size_t WM_IN = WS_WMIX;
constexpr size_t WM_OUT = WS_WMIX + (size_t)DN_INP * D * 2;
constexpr int CW_BAR = 0;
constexpr int CW_DNQ = 8192;
constexpr int CW_CNT = 4096;
#define XB_TMO      128
#define XB_XCNT(j)  (256  + 64 * (j))
#define XB_XSUB(j)  (1280 + 64 * (j))
#define XB_XGEN(j)  (2304 + 64 * (j))
#define XB_TOP      3328
#define XB_TOPGEN   3392
#define XCD_BAR_WORDS 3456
#define XB_SPIN_CAP (1u << 18)

__device__ __forceinline__ unsigned xb_ld(unsigned* p)              { return __hip_atomic_load(p, __ATOMIC_RELAXED, __HIP_MEMORY_SCOPE_AGENT); }
__device__ __forceinline__ unsigned xb_add(unsigned* p, unsigned v) { return __hip_atomic_fetch_add(p, v, __ATOMIC_RELAXED, __HIP_MEMORY_SCOPE_AGENT); }
__device__ __forceinline__ unsigned xb_xcc_id() { return (unsigned)__builtin_amdgcn_s_getreg((3 << 11) | 20) & 0xFu; }
#define XB_SPIN(cond, bar) do { unsigned _sp = 0; while (cond) { __builtin_amdgcn_s_sleep(1); \
    if ((++_sp & 255u) == 0u) { if (xb_ld(&(bar)[XB_TMO])) break; if (_sp > XB_SPIN_CAP) { atomicAdd(&(bar)[XB_TMO], 1u); break; } } } } while (0)

struct XcdBarrier {
    unsigned* bar; unsigned x;
    volatile LAS unsigned* st;
};

__device__ __forceinline__ XcdBarrier xcd_barrier_post(unsigned* bar, volatile LAS unsigned* st) {
    XcdBarrier b; b.bar = bar; b.x = xb_xcc_id(); b.st = st;
    if (threadIdx.x == 0) (void)xb_add(&bar[XB_XCNT(b.x)], 1u);
    return b;
}
__device__ __forceinline__ void xcd_barrier_complete(unsigned* bar, unsigned x, unsigned& nloc, unsigned& nx) {
    const unsigned G = gridDim.x * gridDim.y * gridDim.z;
    unsigned sum, cnt, mine, sp = 0u;
    for (;;) {
        sum = 0u; cnt = 0u; mine = 0u;
#pragma unroll
        for (unsigned j = 0; j < 16; ++j) { const unsigned c = xb_ld(&bar[XB_XCNT(j)]); sum += c; cnt += (c > 0u) ? 1u : 0u; mine = (j == x) ? c : mine; }
        if (sum == G) break;
        __builtin_amdgcn_s_sleep(1);
        if ((++sp & 255u) == 0u) { if (xb_ld(&bar[XB_TMO])) break; if (sp > XB_SPIN_CAP) { atomicAdd(&bar[XB_TMO], 1u); break; } }
    }
    nloc = mine > 0u ? mine : 1u; nx = cnt > 0u ? cnt : 1u;
}

__device__ __forceinline__ void xcd_barrier(const XcdBarrier& b) {
    asm volatile("s_waitcnt vmcnt(0)" ::: "memory");
    __syncthreads();
    if (threadIdx.x == 0) {
        unsigned* bar = b.bar;
        __builtin_amdgcn_s_waitcnt(0);
        unsigned nloc = b.st[0], nx = b.st[1];
        if (nloc == 0u) { xcd_barrier_complete(bar, b.x, nloc, nx); b.st[0] = nloc; b.st[1] = nx; }
        const unsigned old = xb_add(&bar[XB_XSUB(b.x)], 1u);
        const unsigned gen = old / nloc;
        if (old + 1u == (gen + 1u) * nloc) {
            __builtin_amdgcn_fence(__ATOMIC_RELEASE, "agent");
            asm volatile("s_waitcnt vmcnt(0)" ::: "memory");
            const unsigned og = xb_add(&bar[XB_TOP], 1u);
            const unsigned tg = og / nx;
            if (og + 1u == (tg + 1u) * nx) xb_add(&bar[XB_TOPGEN], 1u);
            else XB_SPIN(xb_ld(&bar[XB_TOPGEN]) == tg, bar);
            __builtin_amdgcn_fence(__ATOMIC_ACQUIRE, "agent");
            xb_add(&bar[XB_XGEN(b.x)], 1u);
            asm volatile("s_waitcnt vmcnt(0)" ::: "memory");
        } else {
            XB_SPIN(xb_ld(&bar[XB_XGEN(b.x)]) == gen, bar);
            __builtin_amdgcn_fence(__ATOMIC_ACQUIRE, "agent");
            asm volatile("s_waitcnt vmcnt(0)" ::: "memory");
        }
    }
    __syncthreads();
}

namespace pg8 {
constexpr int BM = 256, BK = 64, HALF = 128, HTB = HALF * BK * 2  , STAGE_BYTES = 8 * HTB;
__host__ __device__ __forceinline__ int lds_byte(int r, int c) { const int st = (r >> 4) * 2 + (c >> 5), rr = r & 15, cc = c & 31, ob = rr * 64 + cc * 2; return st * 1024 + (ob ^ (((ob >> 9) & 1) << 5)); }
__host__ __device__ __forceinline__ void stage_rc(int b, int& R, int& C) { const int st = b / 1024, sb = b % 1024, swz = sb ^ (((sb >> 9) & 1) << 5); R = (st >> 1) * 16 + swz / 64; C = (st & 1) * 32 + (swz % 64) / 2; }
__host__ __device__ __forceinline__ int perm32(int rho) { const int n = rho >> 4, i = rho & 15; return 8 * (i >> 2) + 4 * n + (i & 3); }

struct Unit { const char* A; const char* B; int pm, pn, aux, aux2; };

typedef __bf16 hbf16x2_ __attribute__((ext_vector_type(2)));
DI unsigned cvt_pk_bf16(float lo, float hi) { const f32x2 v = {lo, hi}; return __builtin_bit_cast(unsigned, __builtin_convertvector(v, hbf16x2_)); }

typedef int i32x8_ __attribute__((ext_vector_type(8)));
typedef int i32x4_ __attribute__((ext_vector_type(4)));
DI i32x8_ cat8(const bf16x8& a, const bf16x8& b) { const i32x4_ x = __builtin_bit_cast(i32x4_, a), y = __builtin_bit_cast(i32x4_, b); return __builtin_shufflevector(x, y, 0, 1, 2, 3, 4, 5, 6, 7); }
DI const char* uni_ptr(const char* p) { const unsigned long long v = (unsigned long long)p; const unsigned lo = __builtin_amdgcn_readfirstlane((unsigned)v), hi = __builtin_amdgcn_readfirstlane((unsigned)(v >> 32));
    const char* q = (const char*)(((unsigned long long)hi << 32) | lo); asm volatile("" : "+s"(q)); return q; }
template <class Epi, class Sched, bool GATHER, int FP8 = 0>
__device__ __forceinline__ void gemm_phase(LAS unsigned char* lds, const int tid, const int K, const int lda, const int ldb, const Sched& S, const Epi& E) {
    const int wid = __builtin_amdgcn_readfirstlane(tid >> 6), lane = tid & 63, wr = wid >> 2, wc = wid & 3, fr = lane & 15, fq = lane >> 4;
    const int nt = K / BK;
    unsigned voffA[2], voffB[2]; int rA[2], cA2[2];
#pragma unroll
    for (int i = 0; i < 2; ++i) { int R, C; stage_rc(tid * 16 + i * 8192, R, C); const int Rb = Epi::PERM ? ((R & ~31) + perm32(R & 31)) : R;
        voffA[i] = (unsigned)(R * lda + C) * 2u; voffB[i] = (unsigned)(Rb * ldb + C) * 2u; rA[i] = R; cA2[i] = C * 2; }
    const size_t kstep = (size_t)(BK * 2);
    const size_t hstepA = (size_t)HALF * lda * 2, hstepB = (size_t)HALF * ldb * 2, pstepA = (size_t)64 * lda * 2, pstepB = (size_t)64 * ldb * 2;
    const unsigned ldsw = (unsigned)wid * 1024u;
    const int aoff = lds_byte(wr * 64 + fr, fq * 8), boff = lds_byte(wc * 32 + fr, fq * 8);
#define PG8_SA(b, h) (((b) * 2 + (h)) * HTB)
#define PG8_SB(b, h) ((4 + (b) * 2 + (h)) * HTB)
#define PG8_STAGE(bufoff, gbase, voff) do { _Pragma("unroll") for (int _i = 0; _i < 2; ++_i) { const char* _p = uni_ptr((const char*)(gbase) + (size_t)_i * pstepB); unsigned _o = (voff)[0]; asm volatile("" : "+v"(_o)); \
        __builtin_amdgcn_global_load_lds((const unsigned*)(_p + _o), (LAS unsigned*)(lds + (bufoff) + ldsw + _i * 8192), 16, 0, 0); } } while (0)
#define PG8_STAGE_A(bufoff, gbase, h, usenext) do { _Pragma("unroll") for (int _i = 0; _i < 2; ++_i) { \
        const char* _p = uni_ptr((const char*)(gbase) + (GATHER ? (size_t)0 : (size_t)(h) * hstepA + (size_t)_i * pstepA)); \
        unsigned _o = GATHER ? ((usenext) ? gn[h][_i] : gc[h][_i]) : voffA[0]; asm volatile("" : "+v"(_o)); \
        __builtin_amdgcn_global_load_lds((const unsigned*)(_p + _o), (LAS unsigned*)(lds + (bufoff) + ldsw + _i * 8192), 16, 0, 0); } } while (0)
#define PG8_LDA(dst, b, h) do { _Pragma("unroll") for (int m = 0; m < 4; ++m) _Pragma("unroll") for (int k = 0; k < 2; ++k) dst[m][k] = *(const LAS bf16x8*)(lds + PG8_SA(b, h) + aoff + m * 2048 + k * 1024); } while (0)
#define PG8_LDB(dst, b, h) do { _Pragma("unroll") for (int n = 0; n < 2; ++n) _Pragma("unroll") for (int k = 0; k < 2; ++k) dst[n][k] = *(const LAS bf16x8*)(lds + PG8_SB(b, h) + boff + n * 2048 + k * 1024); } while (0)
#define PG8_MMA(ai, bj, At, Bt) do { __builtin_amdgcn_s_setprio(1); \
        if constexpr (FP8 != 0) { _Pragma("unroll") for (int m = 0; m < 4; ++m) _Pragma("unroll") for (int n = 0; n < 2; ++n) \
            acc[ai][bj][m][n] = __builtin_amdgcn_mfma_scale_f32_16x16x128_f8f6f4(cat8(Bt[n][0], Bt[n][1]), cat8(At[m][0], At[m][1]), acc[ai][bj][m][n], 0, 0, 0, FP8, 0, 0x7f); } \
        else { _Pragma("unroll") for (int m = 0; m < 4; ++m) _Pragma("unroll") for (int n = 0; n < 2; ++n) _Pragma("unroll") for (int k = 0; k < 2; ++k) \
            acc[ai][bj][m][n] = __builtin_amdgcn_mfma_f32_16x16x32_bf16(Bt[n][k], At[m][k], acc[ai][bj][m][n], 0, 0, 0); } \
        __builtin_amdgcn_s_setprio(0); } while (0)
#define PG8_WAIT_V(n) asm volatile("s_waitcnt vmcnt(" #n ")" ::: "memory")
#define PG8_WAIT_L(n) asm volatile("s_waitcnt lgkmcnt(" #n ")" ::: "memory")
#define PG8_BAR __builtin_amdgcn_s_barrier()
#define PG8_SCHED __builtin_amdgcn_sched_barrier(0)
    Unit cur, nxt; int ui = 0;
    if (!S.next(0, cur)) return;
    unsigned gc[2][2], gn[2][2];
    if constexpr (GATHER) {
#pragma unroll
        for (int h = 0; h < 2; ++h)
#pragma unroll
            for (int i = 0; i < 2; ++i) { gc[h][i] = (unsigned)S.grow(cur, h * HALF + rA[i]) * (unsigned)(lda * 2) + (unsigned)cA2[i]; gn[h][i] = gc[h][i]; }
    } else { gc[0][0] = gc[0][1] = gc[1][0] = gc[1][1] = 0u; gn[0][0] = gn[0][1] = gn[1][0] = gn[1][1] = 0u; }
    f32x4 acc[2][2][4][2];
#pragma unroll
    for (int a = 0; a < 2; ++a)
#pragma unroll
        for (int b = 0; b < 2; ++b)
#pragma unroll
            for (int m = 0; m < 4; ++m)
#pragma unroll
                for (int n = 0; n < 2; ++n) acc[a][b][m][n] = (f32x4){0.f, 0.f, 0.f, 0.f};
    bf16x8 At[4][2], B0[2][2], B1[2][2];
    const char* cA = cur.A; const char* cB = cur.B;
    PG8_STAGE(PG8_SB(0, 0), cB, voffB); PG8_STAGE(PG8_SB(0, 1), cB + hstepB, voffB); PG8_STAGE_A(PG8_SA(0, 0), cA, 0, false); PG8_STAGE_A(PG8_SA(0, 1), cA, 1, false);
    if (wr == 1) PG8_BAR;
    PG8_WAIT_V(2); PG8_BAR;
    PG8_STAGE(PG8_SB(1, 0), cB + kstep, voffB); PG8_STAGE_A(PG8_SA(1, 0), cA + kstep, 0, false); PG8_STAGE(PG8_SB(1, 1), cB + hstepB + kstep, voffB);
    PG8_WAIT_V(6); PG8_BAR;
    for (;;) {
        const bool has_next = S.next(ui + 1, nxt);
        const char* nA = has_next ? nxt.A : cA; const char* nB = has_next ? nxt.B : cB;
        if constexpr (GATHER) { if (has_next) {
#pragma unroll
            for (int h = 0; h < 2; ++h)
#pragma unroll
                for (int i = 0; i < 2; ++i) gn[h][i] = (unsigned)S.grow(nxt, h * HALF + rA[i]) * (unsigned)(lda * 2) + (unsigned)cA2[i]; } }
        for (int t = 0; t < nt; t += 2) {
            const bool last = (t == nt - 2);
            const char* a1 = cA + (size_t)(t + 1) * kstep;
            const char* a2 = last ? nA : cA + (size_t)(t + 2) * kstep; const char* b2 = last ? nB : cB + (size_t)(t + 2) * kstep;
            const char* a3 = a2 + kstep; const char* b3 = b2 + kstep;
            PG8_LDB(B0, 0, 0); PG8_LDB(B1, 0, 1); PG8_SCHED; PG8_LDA(At, 0, 0); PG8_STAGE_A(PG8_SA(1, 1), a1, 1, false);
            PG8_WAIT_V(8); PG8_WAIT_L(0); PG8_BAR; PG8_MMA(0, 0, At, B0); PG8_MMA(0, 1, At, B1); PG8_BAR; PG8_SCHED;
            PG8_LDA(At, 0, 1); PG8_STAGE(PG8_SB(0, 0), b2, voffB); PG8_STAGE(PG8_SB(0, 1), b2 + hstepB, voffB); PG8_STAGE_A(PG8_SA(0, 0), a2, 0, last);
            PG8_WAIT_V(8); PG8_WAIT_L(0); PG8_BAR; PG8_MMA(1, 0, At, B0); PG8_MMA(1, 1, At, B1); PG8_BAR; PG8_SCHED;
            PG8_LDB(B0, 1, 0); PG8_LDB(B1, 1, 1); PG8_SCHED; PG8_LDA(At, 1, 0); PG8_STAGE_A(PG8_SA(0, 1), a2, 1, last);
            PG8_WAIT_V(8); PG8_WAIT_L(0); PG8_BAR; PG8_MMA(0, 0, At, B0); PG8_MMA(0, 1, At, B1); PG8_BAR; PG8_SCHED;
            PG8_LDA(At, 1, 1); PG8_STAGE(PG8_SB(1, 0), b3, voffB); PG8_STAGE(PG8_SB(1, 1), b3 + hstepB, voffB); PG8_STAGE_A(PG8_SA(1, 0), a3, 0, last);
            PG8_WAIT_V(8); PG8_WAIT_L(0); PG8_BAR; PG8_MMA(1, 0, At, B0); PG8_MMA(1, 1, At, B1); PG8_BAR; PG8_SCHED;
        }
        if (wr == 0) PG8_BAR;
        { int l_ = lane; asm volatile("" : "+v"(l_)); E(acc, cur, wr, wc, l_ & 15, l_ >> 4); }
        if (!has_next) break;
#pragma unroll
        for (int a = 0; a < 2; ++a)
#pragma unroll
            for (int b = 0; b < 2; ++b)
#pragma unroll
                for (int m = 0; m < 4; ++m)
#pragma unroll
                    for (int n = 0; n < 2; ++n) acc[a][b][m][n] = (f32x4){0.f, 0.f, 0.f, 0.f};
        cur = nxt; cA = nA; cB = nB; ++ui;
        if constexpr (GATHER) {
#pragma unroll
            for (int h = 0; h < 2; ++h)
#pragma unroll
                for (int i = 0; i < 2; ++i) gc[h][i] = gn[h][i]; }
        if (wr == 1) PG8_BAR;
    }
    PG8_WAIT_V(0);
    PG8_BAR;
#undef PG8_SA
#undef PG8_SB
#undef PG8_STAGE
#undef PG8_STAGE_A
#undef PG8_LDA
#undef PG8_LDB
#undef PG8_MMA
#undef PG8_WAIT_V
#undef PG8_WAIT_L
#undef PG8_BAR
#undef PG8_SCHED
}
}
DI float bf2f(bf16_t b) { return __uint_as_float(((unsigned)b) << 16); }

#ifndef EMU8
#define EMU8 0
#endif
DI float q8(float f) { if (EMU8) { unsigned u = __float_as_uint(f); u += 0x7FFFFu + ((u >> 20) & 1u); u &= 0xFFF00000u; return __uint_as_float(u); } return f; }
typedef __bf16 hbf16x2 __attribute__((ext_vector_type(2)));
DI unsigned pk2(float lo, float hi) { const f32x2 v = {lo, hi}; return __builtin_bit_cast(unsigned, __builtin_convertvector(v, hbf16x2)); }
DI float siluf(float x) { return x * __builtin_amdgcn_rcpf(1.0f + __expf(-x)); }
DI float sigmoidf_(float x) { return __builtin_amdgcn_rcpf(1.0f + __expf(-x)); }
DI float softplusf_(float x) { return x > 15.f ? x : __logf(1.0f + __expf(x)); }
DI float wave_sum(float v) {
#pragma unroll
    for (int o = 32; o >= 1; o >>= 1) v += __shfl_xor(v, o);
    return v;
}
DI void unpack8(const u32x4& w, float (&f)[8]) {
    f[0] = __uint_as_float(w.x << 16); f[1] = __uint_as_float(w.x & 0xffff0000u);
    f[2] = __uint_as_float(w.y << 16); f[3] = __uint_as_float(w.y & 0xffff0000u);
    f[4] = __uint_as_float(w.z << 16); f[5] = __uint_as_float(w.z & 0xffff0000u);
    f[6] = __uint_as_float(w.w << 16); f[7] = __uint_as_float(w.w & 0xffff0000u);
}
DI bf16_t f2bf(float f) { return (bf16_t)(pk2(f, 0.f) & 0xffffu); }
DI unsigned pk2q(float lo, float hi) { return pk2(q8(lo), q8(hi)); }
DI u32x4 pack8q(const float (&f)[8]) { u32x4 w; w.x = pk2q(f[0], f[1]); w.y = pk2q(f[2], f[3]); w.z = pk2q(f[4], f[5]); w.w = pk2q(f[6], f[7]); return w; }
DI u32x4 pack8(const float (&f)[8]) { u32x4 w; w.x = pk2(f[0], f[1]); w.y = pk2(f[2], f[3]); w.z = pk2(f[4], f[5]); w.w = pk2(f[6], f[7]); return w; }

constexpr int F8_SH = 3, F8_SACT = 3, F8_SWGU = 10, F8_SWD = 9, F8_SWIN = 10, F8_SWOUT = 10, F8_SY = 1, F8_SYE = 4, F8_SWP = 10, F8_SYT = 2, F8_SCT = 13, F8_SQ = 12, F8_SK = 8, F8_SO = 5;
DI float clamp8(float x) { return __builtin_amdgcn_fmed3f(x, -448.0f, 448.0f); }
typedef float f32x2_ __attribute__((ext_vector_type(2)));
DI f32x4 unpk4f8(unsigned w) { const f32x2_ lo = __builtin_amdgcn_cvt_pk_f32_fp8((int)w, false), hi = __builtin_amdgcn_cvt_pk_f32_fp8((int)w, true); return (f32x4){lo[0], lo[1], hi[0], hi[1]}; }
DI unsigned char f2f8(float a) { return (unsigned char)(__builtin_amdgcn_cvt_pk_fp8_f32(clamp8(a), 0.f, 0, false) & 0xff); }
DI u32x2 f8x4_to_bf16x4(unsigned w) { const f32x4 f = unpk4f8(w); u32x2 o; o.x = (__float_as_uint(f[0]) >> 16) | (__float_as_uint(f[1]) & 0xffff0000u); o.y = (__float_as_uint(f[2]) >> 16) | (__float_as_uint(f[3]) & 0xffff0000u); return o; }
DI unsigned pk4f8(float a, float b, float c, float d) { int w = 0; w = __builtin_amdgcn_cvt_pk_fp8_f32(clamp8(a), clamp8(b), w, false); w = __builtin_amdgcn_cvt_pk_fp8_f32(clamp8(c), clamp8(d), w, true); return (unsigned)w; }

DI bf16x8 lds_frag(const LAS bf16_t* base, int pitch, int row0, int k0, int lane) {
    return *(const LAS bf16x8*)(base + (size_t)(row0 + (lane & 15)) * pitch + k0 + (lane >> 4) * 8);
}
#define MFMA16(a, b, c) __builtin_amdgcn_mfma_f32_16x16x32_bf16((a), (b), (c), 0, 0, 0)

#define CAS __attribute__((address_space(4)))
#define GAS __attribute__((address_space(1)))
typedef const GAS float* cfp_t;
typedef const CAS cfp_t* intab_t;
DI void lds_barrier() { asm volatile("s_waitcnt lgkmcnt(0)" ::: "memory"); __builtin_amdgcn_s_barrier(); asm volatile("" ::: "memory"); }
#ifndef EMUXS
#define EMUXS 0
#endif
DI float rbf(float x) { return EMUXS ? __uint_as_float(pk2(x, 0.f) << 16) : x; }
struct Frame {
    LAS unsigned char* lds; int tid, lane, wave, G, bid;
    intab_t in; float* out; unsigned char* ws; unsigned* ctl;
};
DI const float* INP(const Frame& F, int i) { return (const float*)F.in[i]; }
enum { IN_X = 0, IN_C, IN_CTX, IN_CCTX, IN_ADAW, IN_ADAB, IN_NMIX, IN_NFFN, IN_DNWIN, IN_DNCONV, IN_DNALOG, IN_DNDT, IN_DNNORM, IN_DNWOUT, IN_FNWIN, IN_FNWOUT,
       IN_RW, IN_RB, IN_MG, IN_MU, IN_MD, IN_FNORM };

DI void phase_mod(const Frame& F) {
    LAS float* sc = (LAS float*)F.lds;
    LAS float* red = (LAS float*)(F.lds + 5 * D * 4);
    for (int i = F.tid; i < 5 * D; i += NT) { const int r = i / D, k = i % D; const float v = r < 4 ? INP(F, IN_C)[r * D + k] : INP(F, IN_CCTX)[k]; sc[i] = siluf(v); }
    __syncthreads();
    const int c4 = (F.tid & 15) * 4, ks = F.tid >> 4;
    for (int u = F.bid; u < DEPTH * 192; u += F.G) {
        const int layer = u / 192, n0 = (u % 192) * 64;
        const float* W = INP(F, IN_ADAW) + (size_t)layer * D * (NMOD * D) + n0 + c4;
        f32x4 a0 = {0.f, 0.f, 0.f, 0.f}, a1 = a0, a2 = a0, a3 = a0, a4 = a0;
        const int kb = ks * 64;
        f32x4 wa[4], wb[4];
#define MOD_LOAD(w, k0) _Pragma("unroll") for (int k = 0; k < 4; ++k) w[k] = __builtin_nontemporal_load((const f32x4*)(W + (size_t)(kb + (k0) + k) * (NMOD * D)))
#define MOD_FMA(w, k0) _Pragma("unroll") for (int k = 0; k < 4; ++k) { const int kk = kb + (k0) + k; a0 += w[k] * sc[0 * D + kk]; a1 += w[k] * sc[1 * D + kk]; a2 += w[k] * sc[2 * D + kk]; a3 += w[k] * sc[3 * D + kk]; a4 += w[k] * sc[4 * D + kk]; }
        MOD_LOAD(wa, 0);
#pragma unroll 1
        for (int k0 = 0; k0 < 64; k0 += 8) { MOD_LOAD(wb, k0 + 4); MOD_FMA(wa, k0); if (k0 + 8 < 64) { MOD_LOAD(wa, k0 + 8); } MOD_FMA(wb, k0 + 4); }
#undef MOD_LOAD
#undef MOD_FMA
        *(LAS f32x4*)(red + (ks * 5 + 0) * 64 + c4) = a0; *(LAS f32x4*)(red + (ks * 5 + 1) * 64 + c4) = a1; *(LAS f32x4*)(red + (ks * 5 + 2) * 64 + c4) = a2;
        *(LAS f32x4*)(red + (ks * 5 + 3) * 64 + c4) = a3; *(LAS f32x4*)(red + (ks * 5 + 4) * 64 + c4) = a4;
        __syncthreads();
        if (F.tid < 5 * 64) { const int r = F.tid >> 6, cc = F.tid & 63; float sacc = 0.f;
#pragma unroll
            for (int q = 0; q < 32; ++q) sacc += red[(q * 5 + r) * 64 + cc];
            ((float*)(F.ws + WS_MOD))[((size_t)layer * 5 + r) * (NMOD * D) + n0 + cc] = sacc + INP(F, IN_ADAB)[(size_t)layer * (NMOD * D) + n0 + cc]; }
        __syncthreads();
    }
    {   const float* src = INP(F, IN_FNWIN); bf16_t* dst = (bf16_t*)(F.ws + WS_WB2);
        for (size_t i = ((size_t)F.bid * NT + F.tid) * 8; i < (size_t)2 * D * D; i += (size_t)F.G * NT * 8) {
            const f32x4 a = *(const f32x4*)(src + i), b = *(const f32x4*)(src + i + 4); float f[8] = {a[0], a[1], a[2], a[3], b[0], b[1], b[2], b[3]};
            *(u32x4*)(dst + i) = pack8q(f); } }
    const size_t gt = (size_t)F.bid * NT + F.tid, gs = (size_t)F.G * NT;
    bf16_t* Dt = (bf16_t*)(F.ws + WS_DT);
    for (size_t i = gt; i < (size_t)512 * 512; i += gs) { const int c = (int)(i & 511), jr = (int)(i >> 9);
        const int l = jr <= 256 ? jr : jr - 256; const float a = (float)((l * c) & 511) * (2.0f / 512.0f); const float v = jr <= 256 ? cospif(a) : -sinpif(a); Dt[i] = f2bf(q8(v * 0.04419417382415922f)); }
#if F8FN
    {   unsigned char* CT8 = F.ws + WS_CT;
        for (size_t i16 = gt; i16 < (size_t)4 * 2048 * 2048 / 16; i16 += gs) { const size_t i = i16 * 16; const int t0 = (int)(i & 2047), m = (int)((i >> 11) & 2047), par = (int)((i >> 22) & 1), ty = (int)(i >> 23);
            u32x4 w;
#pragma unroll
            for (int q4 = 0; q4 < 4; ++q4) { float f[4];
#pragma unroll
                for (int k = 0; k < 4; ++k) { const float a = (float)(((2 * m + par) * (t0 + q4 * 4 + k)) & 4095) * (2.0f / 4096.0f); f[k] = (ty ? sinpif(a) : cospif(a)) * ((float)(1 << F8_SCT) / 64.0f); }
                w[q4] = pk4f8(f[0], f[1], f[2], f[3]); }
            *(u32x4*)(CT8 + i) = w; } }
#else
    bf16_t* CT = (bf16_t*)(F.ws + WS_CT);
    for (size_t i8 = gt; i8 < (size_t)4 * 2048 * 2048 / 8; i8 += gs) { const size_t i = i8 * 8; const int t0 = (int)(i & 2047), m = (int)((i >> 11) & 2047), par = (int)((i >> 22) & 1), ty = (int)(i >> 23);
        float f[8];
#pragma unroll
        for (int k = 0; k < 8; ++k) { const float a = (float)(((2 * m + par) * (t0 + k)) & 4095) * (2.0f / 4096.0f); f[k] = q8((ty ? sinpif(a) : cospif(a)) * (1.0f / 64.0f)); }
        *(u32x4*)(CT + i) = pack8(f); }
#endif
    for (size_t d = gt; d < (size_t)D * NEXP / 4; d += gs) { const int L = (int)(d & 63), q = (int)((d >> 6) & 3), ii = (int)((d >> 8) & 3), j = (int)(d >> 10); const int c = (j * 64 + L) * 4 + ii;
        ((f32x4*)(F.ws + WS_RWP))[d] = *(const f32x4*)(INP(F, IN_RW) + (size_t)c * NEXP + q * 4); }
    bf16_t* CT2 = (bf16_t*)(F.ws + WS_CT2);
    for (size_t i = gt; i < (size_t)2 * 256 * 256; i += gs) { const int t = (int)(i & 255), k = (int)((i >> 8) & 255), ty = (int)(i >> 16);
        const float a = (float)((k * t) & 255) * (2.0f / 256.0f); const float v = ty ? sinpif(a) : cospif(a); CT2[i] = f2bf(q8(v * (1.0f / 16.0f))); }
}

struct CvtJob { const float* src; bf16_t* dst; int N, ldd, k0, n0, map, f8; };
DI int cvt_total(int layer) { return ((layer & 1) == 0 ? 16 * 65 + 256 : 256) + 3 * 1024; }
DI void cvt_job(const Frame& F, int layer, int t, CvtJob& J) {
    const bool dn = (layer & 1) == 0; const int j = layer >> 1;
    const int t_in = dn ? 16 * 65 : 0, t_out = 256, t_g = 1024, t_u = 1024;
    int q = t;
    if (q < t_in) { J.src = INP(F, IN_DNWIN) + (size_t)j * D * DN_IN; J.N = DN_IN; J.dst = (bf16_t*)(F.ws + WM_IN); J.ldd = D; J.k0 = (q / 65) * 128; J.n0 = (q % 65) * 128; J.map = 0; J.f8 = F8G1 ? F8_SWIN : 0; return; }
    q -= t_in;
    if (q < t_out) { J.src = (dn ? INP(F, IN_DNWOUT) : INP(F, IN_FNWOUT)) + (size_t)j * D * D; J.N = D; J.dst = (bf16_t*)(F.ws + WM_OUT); J.ldd = D; J.k0 = (q / 16) * 128; J.n0 = (q % 16) * 128; J.map = dn ? 0 : 3; J.f8 = (F8G2 && (dn || F8G2F)) ? F8_SWOUT : 0; return; }
    q -= t_out;
    if (q < t_g) { const int e = q / 64, r = q % 64; J.src = INP(F, IN_MG) + ((size_t)layer * NEXP + e) * D * DFF; J.N = DFF; J.dst = (bf16_t*)(F.ws + WS_WGU + (size_t)e * 1024 * D); J.ldd = D; J.k0 = (r / 4) * 128; J.n0 = (r % 4) * 128; J.map = 1; J.f8 = F8_SWGU; return; }
    q -= t_g;
    if (q < t_u) { const int e = q / 64, r = q % 64; J.src = INP(F, IN_MU) + ((size_t)layer * NEXP + e) * D * DFF; J.N = DFF; J.dst = (bf16_t*)(F.ws + WS_WGU + (size_t)e * 1024 * D); J.ldd = D; J.k0 = (r / 4) * 128; J.n0 = (r % 4) * 128; J.map = 2; J.f8 = F8_SWGU; return; }
    q -= t_u;
    { const int e = q / 64, r = q % 64; J.src = INP(F, IN_MD) + ((size_t)layer * NEXP + e) * DFF * D; J.N = D; J.dst = (bf16_t*)(F.ws + WS_WD + (size_t)e * D * DFF); J.ldd = DFF; J.k0 = (r / 16) * 128; J.n0 = (r % 16) * 128; J.map = 0; J.f8 = F8_SWD; }
}
DI void cvt_load(const CvtJob& J, int kr, int c4, f32x4 (&pv)[8]) {
    const bool inb = J.n0 + c4 < J.N;
#pragma unroll
    for (int jj = 0; jj < 8; ++jj) { const int kk = J.k0 + kr + 16 * jj; f32x4 v = {0.f, 0.f, 0.f, 0.f};
        if (J.map != 3) { if (inb) v = __builtin_nontemporal_load((const f32x4*)(J.src + (size_t)kk * J.N + J.n0 + c4)); }
        else { const int g = kk >> 9, jr = kk & 511, l = jr <= 256 ? jr : jr - 256;
            v = __builtin_nontemporal_load((const f32x4*)(J.src + (size_t)(g * 512 + l) * D + J.n0 + c4));
            if (jr != 0 && jr != 256) { const f32x4 v2 = __builtin_nontemporal_load((const f32x4*)(J.src + (size_t)(g * 512 + 512 - l) * D + J.n0 + c4)); v = jr < 256 ? v + v2 : v - v2; } }
        pv[jj] = v; }
}
DI void phase_cvt(const Frame& F, int layer) {
    const int total = cvt_total(layer);
    LAS float* T = (LAS float*)F.lds;
    const int kr = F.tid >> 5, c4 = (F.tid & 31) * 4;
    f32x4 pv[8]; CvtJob J;
    if (F.bid < total) { cvt_job(F, layer, F.bid, J); cvt_load(J, kr, c4, pv); }
    int buf = 0;
    for (int t = F.bid; t < total; t += F.G, buf ^= 1) {
        LAS float* Tb = T + buf * (128 * 129);
#pragma unroll
        for (int jj = 0; jj < 8; ++jj) { const int k = kr + 16 * jj; Tb[k * 129 + c4 + 0] = pv[jj][0]; Tb[k * 129 + c4 + 1] = pv[jj][1]; Tb[k * 129 + c4 + 2] = pv[jj][2]; Tb[k * 129 + c4 + 3] = pv[jj][3]; }
        const CvtJob C = J;
        if (t + F.G < total) { cvt_job(F, layer, t + F.G, J); cvt_load(J, kr, c4, pv); }
        __syncthreads();
        {   const int n = F.tid >> 2, kq = F.tid & 3;
            const int nn = C.n0 + n; int row = nn; if (C.map == 1) row = (nn >> 7) * 256 + (nn & 127); if (C.map == 2) row = (nn >> 7) * 256 + 128 + (nn & 127);
            if (nn < C.N) {
                if (C.f8) { const float sc8 = __int_as_float((127 + C.f8) << 23); unsigned char* d8 = (unsigned char*)C.dst + (size_t)row * C.ldd + C.k0;
#pragma unroll
                    for (int i = 0; i < 2; ++i) { const int k16 = (kq + 4 * i) * 16; u32x4 w;
#pragma unroll
                        for (int q4 = 0; q4 < 4; ++q4) { const LAS float* tp = Tb + (k16 + q4 * 4) * 129 + n; w[q4] = pk4f8(tp[0] * sc8, tp[129] * sc8, tp[258] * sc8, tp[387] * sc8); }
                        *(u32x4*)(d8 + k16) = w; } }
                else {
#pragma unroll
                for (int i = 0; i < 4; ++i) { const int k8 = (kq + 4 * i) * 8; float f[8];
#pragma unroll
                    for (int jj = 0; jj < 8; ++jj) f[jj] = Tb[(k8 + jj) * 129 + n];
                    *(u32x4*)(C.dst + (size_t)row * C.ldd + C.k0 + k8) = pack8q(f); } } } }
    }
    __syncthreads();
}
constexpr int MISC_OFF = 131072;
DI const float* modp(const Frame& F, int layer, int mrow, int which) { return (const float*)(F.ws + WS_MOD) + ((size_t)layer * 5 + mrow) * (NMOD * D) + (size_t)which * D; }
DI int mod_row(int r) { return r < NLAT ? (r >> 12) : 4; }

DI void moe_prefix_to_lds(const Frame& F, int layer) {
    LAS int* pre = (LAS int*)(F.lds + MISC_OFF);
    if (F.tid < NEXP) pre[32 + F.tid] = (int)__hip_atomic_load(F.ctl + CW_CNT + (layer * NEXP + F.tid) * 64, __ATOMIC_RELAXED, __HIP_MEMORY_SCOPE_AGENT);
    __syncthreads();
    if (F.tid == 0) { int acc = 0;
#pragma unroll
        for (int e = 0; e < NEXP; ++e) { pre[e] = acc; acc += (pre[32 + e] + 255) >> 8; }
        pre[16] = acc; }
    __syncthreads();
}

DI LAS float* tvec(const Frame& F, int idx) { return (LAS float*)F.lds + idx * D; }
DI void thin_fill_vecs(const Frame& F, const float* nw, int layer_mod, int which0, int layer_gate) {
    for (int i = F.tid; i < 16 * (D / 4); i += NT) { const int v = i / (D / 4), c4 = (i % (D / 4)) * 4; const float* src = nullptr;
        if (v == 0) src = nw;
        else { const int mr = (v - 1) / 3, k = (v - 1) % 3; if (k < 2) { if (layer_mod >= 0) src = modp(F, layer_mod, mr, which0 + k); } else if (layer_gate >= 0) src = modp(F, layer_gate, mr, 5); }
        if (src) *(LAS f32x4*)(tvec(F, v) + c4) = *(const f32x4*)(src + c4); }
    __syncthreads();
}
struct Rt { int e1, p1, e2, p2; float w1, w2; };
struct RawRow { u32x2 xs[8]; unsigned ya[8], yb[8]; float w1s, w2s; };
DI Rt rt_load(const Frame& F, int layer, int r) { Rt t = {0, 0, 0, 0, 0.f, 0.f};
    if (layer > 0) { const int* rt = (const int*)(F.ws + WS_ROUTE) + (size_t)r * 8; const u32x4 a = *(const u32x4*)rt; const u32x2 b = *(const u32x2*)(rt + 4);
        t.e1 = (int)a[0]; t.p1 = (int)a[1]; t.e2 = (int)a[2]; t.p2 = (int)a[3]; t.w1 = __uint_as_float(b[0]); t.w2 = __uint_as_float(b[1]); }
    return t; }
DI void raw_xs(const Frame& F, int layer, int r, RawRow& R, f32x4 (&x)[8]) {
    const int c0 = F.lane * 4;
    if (layer == 0) { const float* src = r < NLAT ? INP(F, IN_X) + (size_t)r * D : INP(F, IN_CTX) + (size_t)(r - NLAT) * D;
#pragma unroll
        for (int j = 0; j < 8; ++j) x[j] = *(const f32x4*)(src + j * 256 + c0); }
    else { const bf16_t* src = (const bf16_t*)(F.ws + WS_XS) + (size_t)r * D;
#pragma unroll
        for (int j = 0; j < 8; ++j) R.xs[j] = *(const u32x2*)(src + j * 256 + c0); }
}
DI void raw_y(const Frame& F, int layer, const Rt& t, RawRow& R) {
    if (layer == 0) return;
    const int c0 = F.lane * 4; const LAS int* pre = (const LAS int*)(F.lds + MISC_OFF);
    const unsigned char* y1 = F.ws + WS_YE + ((size_t)pre[t.e1] * 256 + t.p1) * D; const unsigned char* y2 = F.ws + WS_YE + ((size_t)pre[t.e2] * 256 + t.p2) * D;
#pragma unroll
    for (int j = 0; j < 8; ++j) { R.ya[j] = *(const unsigned*)(y1 + j * 256 + c0); R.yb[j] = *(const unsigned*)(y2 + j * 256 + c0); }
    R.w1s = t.w1 * (1.0f / (float)(1 << F8_SYE)); R.w2s = t.w2 * (1.0f / (float)(1 << F8_SYE));
}
DI void raw_finish(const Frame& F, int layer, int r, const RawRow& R, f32x4 (&x)[8]) {
    if (layer == 0) return;
    const int c0 = F.lane * 4; const LAS float* gf = tvec(F, 1 + mod_row(r) * 3 + 2);
#pragma unroll
    for (int j = 0; j < 8; ++j) { const int c = j * 256 + c0; const u32x2 xr = R.xs[j]; const f32x4 g = *(const LAS f32x4*)(gf + c);
        const f32x4 xv = {__uint_as_float(xr.x << 16), __uint_as_float(xr.x & 0xffff0000u), __uint_as_float(xr.y << 16), __uint_as_float(xr.y & 0xffff0000u)};
        x[j] = xv + g * (unpk4f8(R.ya[j]) * R.w1s + unpk4f8(R.yb[j]) * R.w2s); }
}
DI void load_x_pair(const Frame& F, int layer, int rA, int rB, f32x4 (&xA)[8], f32x4 (&xB)[8]) {
    RawRow A, B; const Rt tA = rt_load(F, layer, rA), tB = rt_load(F, layer, rB);
    raw_xs(F, layer, rA, A, xA); raw_xs(F, layer, rB, B, xB);
    raw_y(F, layer, tA, A); raw_y(F, layer, tB, B);
    __builtin_amdgcn_sched_barrier(0);
    raw_finish(F, layer, rA, A, xA); raw_finish(F, layer, rB, B, xB);
}
DI float row_rinv(const f32x4 (&x)[8]) {
    float s = 0.f;
#pragma unroll
    for (int j = 0; j < 8; ++j) s += (x[j][0] * x[j][0] + x[j][1] * x[j][1]) + (x[j][2] * x[j][2] + x[j][3] * x[j][3]);
    s = wave_sum(s);
    return rsqrtf(s * (1.0f / D) + EPS);
}

DI void thin_a_mod(const Frame& F, int r, f32x4 (&h)[8]) {
    bf16_t* xs = (bf16_t*)(F.ws + WS_XS) + (size_t)r * D; const int c0 = F.lane * 4;
#pragma unroll
    for (int j = 0; j < 8; ++j) { u32x2 o; o.x = pk2(h[j][0], h[j][1]); o.y = pk2(h[j][2], h[j][3]); *(u32x2*)(xs + j * 256 + c0) = o; }
    const float rinv = row_rinv(h);
    const LAS float* nw = tvec(F, 0); const LAS float* sh = tvec(F, 1 + mod_row(r) * 3); const LAS float* sc = tvec(F, 1 + mod_row(r) * 3 + 1);
#pragma unroll
    for (int j = 0; j < 8; ++j) { const int c = j * 256 + c0; const f32x4 w = *(const LAS f32x4*)(nw + c), s1 = *(const LAS f32x4*)(sc + c), s0 = *(const LAS f32x4*)(sh + c);
        h[j] = (h[j] * rinv) * w * (s1 + 1.0f) + s0; }
}
DI void thin_a_pair(const Frame& F, int layer, int rA, int rB, f32x4 (&hA)[8], f32x4 (&hB)[8]) { load_x_pair(F, layer, rA, rB, hA, hB); thin_a_mod(F, rA, hA); thin_a_mod(F, rB, hB); }
DI void store_h_row(const Frame& F, int r, const f32x4 (&h)[8], bool f8 = false) {
    const int c0 = F.lane * 4;
    if (f8) { unsigned char* hb = F.ws + WS_HB + (size_t)r * D; const float s = (float)(1 << F8_SH);
#pragma unroll
        for (int j = 0; j < 8; ++j) *(unsigned*)(hb + j * 256 + c0) = pk4f8(h[j][0] * s, h[j][1] * s, h[j][2] * s, h[j][3] * s);
        return; }
    bf16_t* hb = (bf16_t*)(F.ws + WS_HB) + (size_t)r * D;
#pragma unroll
    for (int j = 0; j < 8; ++j) { u32x2 o; o.x = pk2q(h[j][0], h[j][1]); o.y = pk2q(h[j][2], h[j][3]); *(u32x2*)(hb + j * 256 + c0) = o; }
}
DI void phase_thin_a(const Frame& F, int layer, int nrows, bool fold) {
    if (layer > 0) moe_prefix_to_lds(F, layer - 1);
    thin_fill_vecs(F, INP(F, IN_NMIX) + (size_t)layer * D, layer, 0, layer - 1);
    if (fold) {
        for (int pg = F.bid; pg * 8 < NLAT / 2; pg += F.G) { const int p = pg * 8 + F.wave, r1 = (p >> 11) * SEQ + (p & 2047), r2 = r1 + 2048;
            f32x4 h1[8], h2[8]; thin_a_pair(F, layer, r1, r2, h1, h2);
#pragma unroll
            for (int j = 0; j < 8; ++j) { const f32x4 a = h1[j] + h2[j], b = h1[j] - h2[j]; h1[j] = a; h2[j] = b; }
            store_h_row(F, r1, h1, F8FN != 0); store_h_row(F, r2, h2, F8FN != 0); }
        for (int t = F.wave * F.G + F.bid; NLAT + 2 * t < nrows; t += 8 * F.G) { const int r = NLAT + 2 * t; f32x4 h1[8], h2[8]; thin_a_pair(F, layer, r, r + 1, h1, h2); store_h_row(F, r, h1, F8FN != 0); store_h_row(F, r + 1, h2, F8FN != 0); }
    } else {
        for (int t = F.wave * F.G + F.bid; 2 * t < nrows; t += 8 * F.G) { const int r = 2 * t; f32x4 h1[8], h2[8]; thin_a_pair(F, layer, r, r + 1, h1, h2); store_h_row(F, r, h1, F8G1 != 0); store_h_row(F, r + 1, h2, F8G1 != 0); }
    }
}

DI void phase_final(const Frame& F) {
    moe_prefix_to_lds(F, DEPTH - 1);
    thin_fill_vecs(F, INP(F, IN_FNORM), -1, 0, DEPTH - 1);
    const LAS float* nw = tvec(F, 0);
    for (int t = F.wave * F.G + F.bid; 2 * t < NLAT; t += 8 * F.G) {
        const int r = 2 * t; f32x4 xA[8], xB[8];
        load_x_pair(F, DEPTH, r, r + 1, xA, xB);
        const float rinvA = row_rinv(xA), rinvB = row_rinv(xB); const int c0 = F.lane * 4;
        float* o = F.out + (size_t)r * D;
#pragma unroll
        for (int j = 0; j < 8; ++j) { const int c = j * 256 + c0; const f32x4 w = *(const LAS f32x4*)(nw + c); *(f32x4*)(o + c) = (xA[j] * rinvA) * w; *(f32x4*)(o + D + c) = (xB[j] * rinvB) * w; }
    }
}

DI void top2of4(float v0, float v1, float v2, float v3, int& i1, int& i2, float& sc) {
    i1 = 0; float m = v0; if (v1 > m) { m = v1; i1 = 1; } if (v2 > m) { m = v2; i1 = 2; } if (v3 > m) { m = v3; i1 = 3; }
    float m2 = -INFINITY; i2 = 0;
    if (i1 != 0 && v0 > m2) { m2 = v0; i2 = 0; } if (i1 != 1 && v1 > m2) { m2 = v1; i2 = 1; } if (i1 != 2 && v2 > m2) { m2 = v2; i2 = 2; } if (i1 != 3 && v3 > m2) { m2 = v3; i2 = 3; }
    sc = m + m2;
}
DI float pick4(int i, float a, float b, float c, float d) { return i == 0 ? a : (i == 1 ? b : (i == 2 ? c : d)); }

DI void route_row(const Frame& F, const f32x4 (&lg)[4], int r, const float* rb, LAS unsigned* lcount, LAS int* t) {
    float s[16];
#pragma unroll
    for (int q = 0; q < 4; ++q)
#pragma unroll
        for (int k = 0; k < 4; ++k) s[q * 4 + k] = sigmoidf_(wave_sum(lg[q][k]));
    float sel[16];
#pragma unroll
    for (int e = 0; e < 16; ++e) sel[e] = s[e] + rb[e];
    int a1[4], a2[4]; float gs[4];
#pragma unroll
    for (int g = 0; g < 4; ++g) top2of4(sel[4 * g], sel[4 * g + 1], sel[4 * g + 2], sel[4 * g + 3], a1[g], a2[g], gs[g]);
    int gi = 0; float gm = gs[0]; if (gs[1] > gm) { gm = gs[1]; gi = 1; } if (gs[2] > gm) { gm = gs[2]; gi = 2; } if (gs[3] > gm) { gm = gs[3]; gi = 3; }
    const int i1 = gi == 0 ? a1[0] : (gi == 1 ? a1[1] : (gi == 2 ? a1[2] : a1[3]));
    const int i2 = gi == 0 ? a2[0] : (gi == 1 ? a2[1] : (gi == 2 ? a2[2] : a2[3]));
    const float t0 = pick4(gi, s[0], s[4], s[8], s[12]), t1 = pick4(gi, s[1], s[5], s[9], s[13]), t2 = pick4(gi, s[2], s[6], s[10], s[14]), t3 = pick4(gi, s[3], s[7], s[11], s[15]);
    const float sv1 = pick4(i1, t0, t1, t2, t3), sv2 = pick4(i2, t0, t1, t2, t3);
    const float inv = 1.0f / (sv1 + sv2);
    const int e1 = gi * 4 + i1, e2 = gi * 4 + i2;
    if (F.lane == 0) {
        const unsigned p1 = __hip_atomic_fetch_add(lcount + e1, 1u, __ATOMIC_RELAXED, __HIP_MEMORY_SCOPE_WORKGROUP);
        const unsigned p2 = __hip_atomic_fetch_add(lcount + e2, 1u, __ATOMIC_RELAXED, __HIP_MEMORY_SCOPE_WORKGROUP);
        t[0] = e1; t[1] = (int)p1; t[2] = e2; t[3] = (int)p2; t[4] = __float_as_int(sv1 * inv); t[5] = __float_as_int(sv2 * inv); t[6] = r; }
}

#ifndef TBR
#define TBR 2
#endif
DI void phase_thin_b(const Frame& F, int layer, int nrows) {
    LAS f32x4* RW = (LAS f32x4*)F.lds;
    LAS int* tab = (LAS int*)(F.lds + MISC_OFF + 1024);
    LAS unsigned* lcount = (LAS unsigned*)(F.lds + MISC_OFF + 512);
    LAS unsigned* lbase = (LAS unsigned*)(F.lds + MISC_OFF + 640);
    for (int i = F.tid; i < D * NEXP / 4; i += NT) RW[i] = ((const f32x4*)(F.ws + WS_RWP))[i];
    if (F.tid < 16) lcount[F.tid] = 0u;
    __syncthreads();
    const float* nw = INP(F, IN_NFFN) + (size_t)layer * D; const float* rb = INP(F, IN_RB);
    const int ntask = nrows / TBR;
    int it = 0;
    for (int tk = F.wave * F.G + F.bid; tk < ntask; tk += 8 * F.G, ++it) {
        int ln_ = F.lane; asm volatile("" : "+v"(ln_));
        const int r0 = tk * TBR; u32x2 xp[TBR][8]; const int c0 = ln_ * 4;
        {   const bf16_t* xs = (const bf16_t*)(F.ws + WS_XS) + (size_t)r0 * D;
#pragma unroll
            for (int j = 0; j < 8; ++j)
#pragma unroll
                for (int s2 = 0; s2 < TBR; ++s2) xp[s2][j] = *(const u32x2*)(xs + s2 * D + j * 256 + c0); }
#define UNPK(v) ((f32x4){__uint_as_float((v).x << 16), __uint_as_float((v).x & 0xffff0000u), __uint_as_float((v).y << 16), __uint_as_float((v).y & 0xffff0000u)})
        float rinv[TBR];
#pragma unroll
        for (int s2 = 0; s2 < TBR; ++s2) { float ss = 0.f;
#pragma unroll
            for (int j = 0; j < 8; ++j) { const f32x4 a = UNPK(xp[s2][j]); ss += (a[0] * a[0] + a[1] * a[1]) + (a[2] * a[2] + a[3] * a[3]); }
            rinv[s2] = rsqrtf(wave_sum(ss) * (1.0f / D) + EPS); }
        const float* sh = modp(F, layer, mod_row(r0), 3); const float* sc = modp(F, layer, mod_row(r0), 4);
        unsigned char* hb = F.ws + WS_HB + (size_t)r0 * D;
        f32x4 lg[TBR][4];
#pragma unroll
        for (int s2 = 0; s2 < TBR; ++s2)
#pragma unroll
            for (int q = 0; q < 4; ++q) lg[s2][q] = (f32x4){0.f, 0.f, 0.f, 0.f};
#pragma unroll
        for (int jh = 0; jh < 2; ++jh) {
            f32x4 wv[4], s1v[4], s0v[4];
#pragma unroll
            for (int jj = 0; jj < 4; ++jj) { const int c = (jh * 4 + jj) * 256 + c0; wv[jj] = *(const f32x4*)(nw + c); s1v[jj] = *(const f32x4*)(sc + c); s0v[jj] = *(const f32x4*)(sh + c); }
            __builtin_amdgcn_sched_barrier(0);
#pragma unroll
            for (int jj = 0; jj < 4; ++jj) { const int j = jh * 4 + jj; const int c = j * 256 + c0;
                const f32x4 ws1 = wv[jj] * (s1v[jj] + 1.0f); const float s8 = (float)(1 << F8_SH);
                f32x4 h[TBR];
#pragma unroll
                for (int s2 = 0; s2 < TBR; ++s2) { h[s2] = (UNPK(xp[s2][j]) * rinv[s2]) * ws1 + s0v[jj]; *(unsigned*)(hb + s2 * D + c) = pk4f8(h[s2][0] * s8, h[s2][1] * s8, h[s2][2] * s8, h[s2][3] * s8); }
#pragma unroll
                for (int i = 0; i < 4; ++i) { f32x4 rw[4];
#pragma unroll
                    for (int q = 0; q < 4; ++q) rw[q] = RW[((j * 4 + i) * 4 + q) * 64 + ln_];
#pragma unroll
                    for (int q = 0; q < 4; ++q)
#pragma unroll
                        for (int s2 = 0; s2 < TBR; ++s2) lg[s2][q] += rw[q] * h[s2][i];
                    __builtin_amdgcn_sched_barrier(0); } } }
#undef UNPK
#pragma unroll
        for (int s2 = 0; s2 < TBR; ++s2) asm volatile("" : "+v"(lg[s2][0]), "+v"(lg[s2][1]), "+v"(lg[s2][2]), "+v"(lg[s2][3]));
#pragma unroll
        for (int s2 = 0; s2 < TBR; ++s2) route_row(F, lg[s2], r0 + s2, rb, lcount, tab + (it * (8 * TBR) + F.wave * TBR + s2) * 8);
    }
    __syncthreads();
    if (F.tid < 16) lbase[F.tid] = __hip_atomic_fetch_add(F.ctl + CW_CNT + (layer * NEXP + F.tid) * 64, lcount[F.tid], __ATOMIC_RELAXED, __HIP_MEMORY_SCOPE_AGENT);
    __syncthreads();
    const int nloc = ((ntask + 8 * F.G - 1) / (8 * F.G)) * (8 * TBR);
    for (int i = F.tid; i < nloc; i += NT) { const LAS int* t = tab + i * 8; const int r = t[6]; if (((i / (8 * TBR)) * 8 + (i / TBR) % 8) * F.G + F.bid < ntask) {
            const int e1 = t[0], e2 = t[2]; const int p1 = t[1] + (int)lbase[e1], p2 = t[3] + (int)lbase[e2];
            int* rt = (int*)(F.ws + WS_ROUTE) + (size_t)r * 8; rt[0] = e1; rt[1] = p1; rt[2] = e2; rt[3] = p2; rt[4] = t[4]; rt[5] = t[5];
            int* list = (int*)(F.ws + WS_LIST); list[(size_t)e1 * LIST_CAP + p1] = r; list[(size_t)e2 * LIST_CAP + p2] = r; } }
    __syncthreads();
}

DI void phase_dn_out(const Frame& F, int j, int nrows) {
    const float* nw = INP(F, IN_DNNORM) + (size_t)j * HD;
    for (int rg = F.bid; rg * 8 < nrows; rg += F.G) {
        const int r = rg * 8 + F.wave; const int c0 = F.lane * 32;
        const bf16_t* o0 = (const bf16_t*)(F.ws + SC_O) + (size_t)r * D + c0; const bf16_t* o1 = o0 + (size_t)NR * D;
        const bf16_t* gp = (const bf16_t*)(F.ws + SC_P) + (size_t)r * 8192 + 6144 + c0;
        float v[32]; float ss = 0.f;
#if F8O
        {   const unsigned char* p0 = F.ws + SC_O + (size_t)r * D + c0; const unsigned char* p1 = p0 + (size_t)NR * D;
#pragma unroll
            for (int q = 0; q < 2; ++q) { const u32x4 wa = *(const u32x4*)(p0 + q * 16), wb = *(const u32x4*)(p1 + q * 16);
#pragma unroll
                for (int q4 = 0; q4 < 4; ++q4) { const f32x4 a = unpk4f8(wa[q4]), b = unpk4f8(wb[q4]);
#pragma unroll
                    for (int k = 0; k < 4; ++k) { const float x = (a[k] + b[k]) * (1.0f / (float)(1 << F8_SO)); v[q * 16 + q4 * 4 + k] = x; ss += x * x; } } } }
#else
#pragma unroll
        for (int q = 0; q < 4; ++q) { float a[8], b[8]; unpack8(*(const u32x4*)(o0 + q * 8), a); unpack8(*(const u32x4*)(o1 + q * 8), b);
#pragma unroll
            for (int k = 0; k < 8; ++k) { v[q * 8 + k] = a[k] + b[k]; ss += v[q * 8 + k] * v[q * 8 + k]; } }
#endif
        ss += __shfl_xor(ss, 1); ss += __shfl_xor(ss, 2);
        const float rinv = rsqrtf(ss * (1.0f / HD) + EPS);
        const int hc = (F.lane & 3) * 32;
#if F8G2
        unsigned char* y = F.ws + WS_HB + (size_t)r * D + c0;
#pragma unroll
        for (int q = 0; q < 4; q += 2) { u32x4 w;
#pragma unroll
            for (int q2 = 0; q2 < 2; ++q2) { float g[8], o[8]; unpack8(*(const u32x4*)(gp + (q + q2) * 8), g);
#pragma unroll
                for (int k = 0; k < 8; ++k) o[k] = v[(q + q2) * 8 + k] * rinv * nw[hc + (q + q2) * 8 + k] * siluf(g[k]) * (float)(1 << F8_SY);
                w[q2 * 2] = pk4f8(o[0], o[1], o[2], o[3]); w[q2 * 2 + 1] = pk4f8(o[4], o[5], o[6], o[7]); }
            *(u32x4*)(y + q * 8) = w; }
#else
        bf16_t* y = (bf16_t*)(F.ws + WS_HB) + (size_t)r * D + c0;
#pragma unroll
        for (int q = 0; q < 4; ++q) { float g[8], o[8]; unpack8(*(const u32x4*)(gp + q * 8), g);
#pragma unroll
            for (int k = 0; k < 8; ++k) o[k] = v[q * 8 + k] * rinv * nw[hc + q * 8 + k] * siluf(g[k]);
            *(u32x4*)(y + q * 8) = pack8q(o); }
#endif
    }
}
DI int chunk_row0(int b, int cc) { return cc < 4 ? NLAT + b * CTXL + cc * 64 : b * SEQ + (cc - 4) * 64; }

#ifndef DREP
#define DREP 0
#endif
DI void phase_dn_a(const Frame& F, int j) {
    LAS bf16_t* qn = (LAS bf16_t*)F.lds;
    LAS bf16_t* kTl = (LAS bf16_t*)F.lds;
    LAS bf16_t* kn = (LAS bf16_t*)(F.lds + 18432);
    LAS bf16_t* vTl = (LAS bf16_t*)(F.lds + 35840);
    LAS float* KK = (LAS float*)(F.lds + 54272);
    LAS float* QK = KK + 64 * 65;
    LAS bf16_t* TmB = (LAS bf16_t*)(F.lds + 54272);
    LAS bf16_t* TmW = TmB + 64 * 72;
    LAS float* Lm = (LAS float*)(F.lds + 87552);
    LAS float* gv = (LAS float*)(F.lds + 122368);
    LAS float* abv = (LAS float*)(F.lds + 124416);
    LAS float* cwl = (LAS float*)(F.lds + 125440);
    LAS float* Mb = cwl;
    LAS bf16_t* raw = (LAS bf16_t*)(F.lds + 54272);
    const bf16_t* P = (const bf16_t*)(F.ws + SC_P); const float* AB = (const float*)(F.ws + SC_AB);
    const float* cw = INP(F, IN_DNCONV) + (size_t)j * 5 * 6144;
    u32x4 pr[6], ph; f32x4 pcw; float pab;
#define DNA_PREFETCH(uu) do { const int pb_ = (uu) / (HEADS * NCH), ph_ = ((uu) / NCH) % HEADS, pc_ = (uu) % NCH; const int prow_ = chunk_row0(pb_, pc_); \
        _Pragma("unroll") for (int i_ = 0; i_ < 6; ++i_) { const int it_ = i_ * NT + ptid, w_ = it_ & 1023; \
            pr[i_] = *(const u32x4*)(P + (size_t)(prow_ + (w_ >> 4)) * 8192 + (it_ >> 10) * 2048 + ph_ * HD + (w_ & 15) * 8); } \
        ph = (u32x4){0u, 0u, 0u, 0u}; \
        if (ptid < 192) { const int rr_ = (ptid >> 4) & 3, tt_ = rr_ < 2 ? rr_ - 2 : 62 + rr_; const int pos_ = pc_ * 64 + tt_; \
            if (pc_ < 4 && pos_ >= 0 && pos_ < CTXL) ph = *(const u32x4*)(P + (size_t)(prow_ + tt_) * 8192 + (ptid >> 6) * 2048 + ph_ * HD + (ptid & 15) * 8); } \
        pab = 0.f; if (ptid < 256) pab = AB[(size_t)(prow_ + (ptid & 63)) * 64 + (ptid >> 6) * 16 + ph_]; \
        pcw = (f32x4){0.f, 0.f, 0.f, 0.f}; if (ptid < 480) { const int ix_ = ptid * 4, tap_ = ix_ / 384, c_ = ix_ % 384; pcw = *(const f32x4*)(cw + tap_ * 6144 + (c_ >> 7) * 2048 + ph_ * HD + (c_ & 127)); } } while (0)
    { int ptid = F.tid; asm volatile("" : "+v"(ptid)); if (F.bid < NUNIT) DNA_PREFETCH(F.bid); }
    for (int u = F.bid; u < NUNIT; u += F.G) {
        int tid = F.tid;
#define REOPQ() asm volatile("" : "+v"(tid)); const int lane = tid & 63, quad = lane >> 4, l15 = lane & 15; (void)quad; (void)l15; (void)lane;
        const int h = (u / NCH) % HEADS;
        { REOPQ()
#pragma unroll
        for (int i = 0; i < 6; ++i) { const int it = i * NT + tid, w = it & 1023; *(LAS u32x4*)(raw + ((it >> 10) * 68 + (w >> 4) + 2) * 128 + (w & 15) * 8) = pr[i]; }
        if (tid < 192) { const int rr = (tid >> 4) & 3; *(LAS u32x4*)(raw + ((tid >> 6) * 68 + (rr < 2 ? rr : 64 + rr)) * 128 + (tid & 15) * 8) = ph; }
        if (tid < 256) abv[tid] = pab;
        if (tid < 480) *(LAS f32x4*)(cwl + tid * 4) = pcw;
        lds_barrier();
        { const int ptid = tid; if (u + F.G < NUNIT) DNA_PREFETCH(u + F.G); }
        }{ REOPQ()
        for (int rep_ = 0; rep_ < ((DREP >> 0) & 1) + 1; ++rep_) {
#pragma unroll
        for (int part = 0; part < 3; ++part) {
            const int cg = tid & 15;
            f32x2 wt[5][4];
#pragma unroll
            for (int dt = 0; dt < 5; ++dt) { const f32x4 w0 = *(const LAS f32x4*)(cwl + dt * 384 + part * 128 + cg * 8), w1 = *(const LAS f32x4*)(cwl + dt * 384 + part * 128 + cg * 8 + 4);
                wt[dt][0] = (f32x2){w0[0], w0[1]}; wt[dt][1] = (f32x2){w0[2], w0[3]}; wt[dt][2] = (f32x2){w1[0], w1[1]}; wt[dt][3] = (f32x2){w1[2], w1[3]}; }
#pragma unroll
            for (int sub = 0; sub < 2; ++sub) {
                const int t = (sub * NT + tid) >> 4;
                u32x4 rv[5];
#pragma unroll
                for (int dt = 0; dt < 5; ++dt) rv[dt] = *(const LAS u32x4*)(raw + (part * 68 + t + dt) * 128 + cg * 8);
                __builtin_amdgcn_sched_barrier(0);
                f32x2 acc[4] = {{0.f, 0.f}, {0.f, 0.f}, {0.f, 0.f}, {0.f, 0.f}};
#pragma unroll
                for (int dt = 0; dt < 5; ++dt) {
                    const f32x2 v0 = {__uint_as_float(rv[dt].x << 16), __uint_as_float(rv[dt].x & 0xffff0000u)}, v1 = {__uint_as_float(rv[dt].y << 16), __uint_as_float(rv[dt].y & 0xffff0000u)};
                    const f32x2 v2 = {__uint_as_float(rv[dt].z << 16), __uint_as_float(rv[dt].z & 0xffff0000u)}, v3 = {__uint_as_float(rv[dt].w << 16), __uint_as_float(rv[dt].w & 0xffff0000u)};
                    acc[0] = __builtin_elementwise_fma(v0, wt[dt][0], acc[0]); acc[1] = __builtin_elementwise_fma(v1, wt[dt][1], acc[1]);
                    acc[2] = __builtin_elementwise_fma(v2, wt[dt][2], acc[2]); acc[3] = __builtin_elementwise_fma(v3, wt[dt][3], acc[3]); }
                f32x2 ss2 = {0.f, 0.f};
#pragma unroll
                for (int k = 0; k < 4; ++k) { f32x2 e; e.x = __builtin_amdgcn_rcpf(1.0f + __expf(-acc[k].x)); e.y = __builtin_amdgcn_rcpf(1.0f + __expf(-acc[k].y)); acc[k] = acc[k] * e; ss2 = __builtin_elementwise_fma(acc[k], acc[k], ss2); }
                if (part < 2) { float ss = ss2.x + ss2.y; ss += __shfl_xor(ss, 1); ss += __shfl_xor(ss, 2); ss += __shfl_xor(ss, 4); ss += __shfl_xor(ss, 8);
                    const float scl = rsqrtf(ss + EPS) * (part == 0 ? 0.08838834764831845f : 1.0f);
                    u32x4 o; o.x = pk2(acc[0].x * scl, acc[0].y * scl); o.y = pk2(acc[1].x * scl, acc[1].y * scl); o.z = pk2(acc[2].x * scl, acc[2].y * scl); o.w = pk2(acc[3].x * scl, acc[3].y * scl);
                    *(LAS u32x4*)((part == 0 ? qn : kn) + t * 136 + cg * 8) = o;
                } else {
#pragma unroll
                    for (int k = 0; k < 4; ++k) { const unsigned pw_ = pk2(acc[k].x, acc[k].y); vTl[(cg * 8 + 2 * k) * 72 + t] = (bf16_t)(pw_ & 0xffffu); vTl[(cg * 8 + 2 * k + 1) * 72 + t] = (bf16_t)(pw_ >> 16); }
                }
            }
        }
        }
        lds_barrier();
        }{ REOPQ()
        if (F.wave < 2) { const int d = F.wave, t = lane;
            const float a = abv[d * 64 + t], bb = abv[128 + d * 64 + t];
            const float Al = __expf(INP(F, IN_DNALOG)[(j * 2 + d) * HEADS + h]), dtb = INP(F, IN_DNDT)[(j * 2 + d) * HEADS + h];
            float g = -Al * softplusf_(a + dtb);
            if (d == 0) {
#pragma unroll
                for (int o = 1; o < 64; o <<= 1) { const float tv = __shfl_up(g, o); if (t >= o) g += tv; }
            } else {
#pragma unroll
                for (int o = 1; o < 64; o <<= 1) { const float tv = __shfl_down(g, o); if (t + o < 64) g += tv; }
            }
            const float be = sigmoidf_(bb);
            gv[d * 64 + t] = g; gv[128 + d * 64 + t] = be; gv[256 + d * 64 + t] = be * __expf(g); }
        }{ REOPQ()
        for (int rep_ = 0; rep_ < ((DREP >> 1) & 1) + 1; ++rep_) {
        {   const int mat = F.wave >> 2, tr = F.wave & 3; const LAS bf16_t* Ap = mat ? qn : kn; LAS float* Out = mat ? QK : KK;
            bf16x8 fa[4], fb[4][4];
#pragma unroll
            for (int ks = 0; ks < 4; ++ks) { fa[ks] = lds_frag(Ap, 136, tr * 16, ks * 32, lane);
#pragma unroll
                for (int tc = 0; tc < 4; ++tc) fb[tc][ks] = lds_frag(kn, 136, tc * 16, ks * 32, lane); }
            __builtin_amdgcn_sched_barrier(0);
#pragma unroll
            for (int tc = 0; tc < 4; ++tc) { f32x4 acc = {0.f, 0.f, 0.f, 0.f};
#pragma unroll
                for (int ks = 0; ks < 4; ++ks) acc = MFMA16(fa[ks], fb[tc][ks], acc);
#pragma unroll
                for (int jj = 0; jj < 4; ++jj) Out[(tr * 16 + 4 * quad + jj) * 65 + tc * 16 + l15] = acc[jj]; }
#if F8QK
            {   unsigned char* QN8 = F.ws + SC_QN; const int t = tid >> 3, c16 = (tid & 7) * 16; const float sq = (float)(1 << F8_SQ);
                float fa_[8], fb_[8]; { const u32x4 a_ = *(const LAS u32x4*)(qn + t * 136 + c16), b_ = *(const LAS u32x4*)(qn + t * 136 + c16 + 8); unpack8(a_, fa_); unpack8(b_, fb_); }
                u32x4 w; w.x = pk4f8(fa_[0] * sq, fa_[1] * sq, fa_[2] * sq, fa_[3] * sq); w.y = pk4f8(fa_[4] * sq, fa_[5] * sq, fa_[6] * sq, fa_[7] * sq);
                w.z = pk4f8(fb_[0] * sq, fb_[1] * sq, fb_[2] * sq, fb_[3] * sq); w.w = pk4f8(fb_[4] * sq, fb_[5] * sq, fb_[6] * sq, fb_[7] * sq);
                *(u32x4*)(QN8 + ((size_t)u * 64 + t) * 128 + c16) = w; } }
#else
            bf16_t* QN = (bf16_t*)(F.ws + SC_QN);
#pragma unroll
            for (int i = 0; i < 2; ++i) { const int item = tid + NT * i, t = item >> 4, c8 = item & 15;
                *(u32x4*)(QN + ((size_t)u * 64 + t) * 128 + c8 * 8) = *(const LAS u32x4*)(qn + t * 136 + c8 * 8); } }
#endif
        }
        lds_barrier();
        }{ REOPQ()
        for (int rep_ = 0; rep_ < ((DREP >> 2) & 1) + 1; ++rep_) {
        {   const int c = tid >> 3, s0 = (tid & 7) * 8;
            const float gfc = gv[c], gbc = gv[64 + c], bfc = gv[128 + c], bbc = gv[192 + c];
            float af[8], ab[8], kkv[8], qkv[8], gfs[8], gbs[8];
#pragma unroll
            for (int k = 0; k < 8; ++k) { kkv[k] = KK[c * 65 + s0 + k]; qkv[k] = QK[c * 65 + s0 + k]; gfs[k] = gv[s0 + k]; gbs[k] = gv[64 + s0 + k]; }
            __builtin_amdgcn_sched_barrier(0);
#pragma unroll
            for (int k = 0; k < 8; ++k) { const int sx = s0 + k; const float kk = kkv[k], qk = qkv[k];
                const float df = __expf(sx <= c ? gfc - gfs[k] : 0.f), db = __expf(sx >= c ? gbc - gbs[k] : 0.f);
                Lm[c * 68 + sx] = sx < c ? bfc * kk * df : 0.f;
                Lm[4352 + (63 - c) * 68 + (63 - sx)] = sx > c ? bbc * kk * db : 0.f;
                af[k] = sx <= c ? qk * df : 0.f; ab[k] = sx >= c ? qk * db : 0.f; }
            bf16_t* AI = (bf16_t*)(F.ws + SC_AI);
            *(u32x4*)(AI + ((size_t)u * 64 + c) * 64 + s0) = pack8(af);
            *(u32x4*)(AI + ((size_t)(NUNIT + u) * 64 + c) * 64 + s0) = pack8(ab);
            if (tid < 128) ((float*)(F.ws + SC_G))[((size_t)(tid >> 6) * NUNIT + u) * 64 + (tid & 63)] = gv[tid];
            bf16_t* KT = (bf16_t*)(F.ws + SC_KT);
#pragma unroll
            for (int i = 0; i < 2; ++i) { const int item = tid + NT * i; const int dk = item & 127, tg = item >> 7; unsigned short hv[8];
#pragma unroll
                for (int k = 0; k < 8; ++k) hv[k] = kn[(tg * 8 + k) * 136 + dk];
                u32x4 pk_; pk_.x = (unsigned)hv[0] | ((unsigned)hv[1] << 16); pk_.y = (unsigned)hv[2] | ((unsigned)hv[3] << 16); pk_.z = (unsigned)hv[4] | ((unsigned)hv[5] << 16); pk_.w = (unsigned)hv[6] | ((unsigned)hv[7] << 16);
#if F8QK
                {   float f_[8]; unpack8(pk_, f_); const float sk = (float)(1 << F8_SK); u32x2 w8; w8.x = pk4f8(f_[0] * sk, f_[1] * sk, f_[2] * sk, f_[3] * sk); w8.y = pk4f8(f_[4] * sk, f_[5] * sk, f_[6] * sk, f_[7] * sk);
                    *(u32x2*)((unsigned char*)KT + ((size_t)u * 128 + dk) * 64 + tg * 8) = w8; }
#else
                *(u32x4*)(KT + ((size_t)u * 128 + dk) * 64 + tg * 8) = pk_;
#endif
                *(LAS u32x4*)(kTl + dk * 72 + tg * 8) = pk_; } }
        }
        lds_barrier();
        }{ REOPQ()
        for (int rep_ = 0; rep_ < ((DREP >> 3) & 1) + 1; ++rep_) {
        {
            if (tid < 128) { const int d = tid >> 6, blk = (tid >> 4) & 3, col = tid & 15; LAS float* Lb = Lm + d * 4352 + (blk * 16) * 68 + blk * 16; float x[16];
#pragma unroll
                for (int rg = 0; rg < 4; ++rg) { f32x4 lr[4][4];
#pragma unroll
                    for (int a_ = 0; a_ < 4; ++a_)
#pragma unroll
                        for (int q = 0; q <= rg; ++q) lr[a_][q] = *(const LAS f32x4*)(Lb + (rg * 4 + a_) * 68 + q * 4);
                    __builtin_amdgcn_sched_barrier(0);
#pragma unroll
                    for (int a_ = 0; a_ < 4; ++a_) { const int r = rg * 4 + a_; float acc = (r == col) ? 1.0f : 0.0f;
#pragma unroll
                        for (int sx = 0; sx < r; ++sx) acc -= lr[a_][sx >> 2][sx & 3] * x[sx];
                        x[r] = acc; } }
#pragma unroll
                for (int r = 0; r < 16; ++r) Lb[r * 68 + col] = x[r]; }
            lds_barrier();
#pragma unroll 1
            for (int i = 1; i < 4; ++i) {
                const int nstrip = i * 64;
                if (tid < 2 * nstrip) { const int d = tid >= nstrip ? 1 : 0, rem = tid - d * nstrip, jb = rem >> 6, r = (rem >> 2) & 15, c4 = (rem & 3) * 4;
                    const LAS float* Lr = Lm + d * 4352 + (i * 16 + r) * 68; const LAS float* Tc = Lm + d * 4352 + jb * 16 + c4; f32x4 acc = {0.f, 0.f, 0.f, 0.f};
#pragma unroll 1
                    for (int kb = jb; kb < i; ++kb) { f32x4 lv[4], tv4[16];
#pragma unroll
                        for (int q = 0; q < 4; ++q) lv[q] = *(const LAS f32x4*)(Lr + kb * 16 + q * 4);
#pragma unroll
                        for (int q = 0; q < 16; ++q) tv4[q] = *(const LAS f32x4*)(Tc + (kb * 16 + q) * 68);
                        __builtin_amdgcn_sched_barrier(0);
#pragma unroll
                        for (int q = 0; q < 16; ++q) acc += tv4[q] * lv[q >> 2][q & 3]; }
                    *(LAS f32x4*)(Mb + ((d * 3 + jb) * 16 + r) * 16 + c4) = acc; }
                lds_barrier();
                if (tid < 2 * nstrip) { const int d = tid >= nstrip ? 1 : 0, rem = tid - d * nstrip, jb = rem >> 6, r = (rem >> 2) & 15, c4 = (rem & 3) * 4;
                    const LAS float* Dr = Lm + d * 4352 + (i * 16 + r) * 68 + i * 16; const LAS float* Mc = Mb + (d * 3 + jb) * 256 + c4; f32x4 lv[4], mv[16];
#pragma unroll
                    for (int q = 0; q < 4; ++q) lv[q] = *(const LAS f32x4*)(Dr + q * 4);
#pragma unroll
                    for (int q = 0; q < 16; ++q) mv[q] = *(const LAS f32x4*)(Mc + q * 16);
                    __builtin_amdgcn_sched_barrier(0);
                    f32x4 acc = {0.f, 0.f, 0.f, 0.f};
#pragma unroll
                    for (int q = 0; q < 16; ++q) acc += mv[q] * lv[q >> 2][q & 3];
                    *(LAS f32x4*)(Lm + d * 4352 + (i * 16 + r) * 68 + jb * 16 + c4) = -acc; }
                lds_barrier();
            } }
        }
        }{ REOPQ()
        for (int rep_ = 0; rep_ < ((DREP >> 4) & 1) + 1; ++rep_) {
#pragma unroll 1
        for (int d = 0; d < 2; ++d) {
            {   const int r = tid >> 3, c0 = (tid & 7) * 8; float tv[8];
                { const f32x4 t0 = *(const LAS f32x4*)(Lm + d * 4352 + r * 68 + c0), t1 = *(const LAS f32x4*)(Lm + d * 4352 + r * 68 + c0 + 4);
                  tv[0] = t0[0]; tv[1] = t0[1]; tv[2] = t0[2]; tv[3] = t0[3]; tv[4] = t1[0]; tv[5] = t1[1]; tv[6] = t1[2]; tv[7] = t1[3]; }
                __builtin_amdgcn_sched_barrier(0);
                const int rr = d ? 63 - r : r, cb = d ? 56 - c0 : c0;
                const f32x4 b0 = *(const LAS f32x4*)(gv + 128 + d * 64 + cb), b1 = *(const LAS f32x4*)(gv + 128 + d * 64 + cb + 4), w0 = *(const LAS f32x4*)(gv + 256 + d * 64 + cb), w1 = *(const LAS f32x4*)(gv + 256 + d * 64 + cb + 4);
                float ob[8], ow[8];
#pragma unroll
                for (int k = 0; k < 8; ++k) { const float v = d ? tv[7 - k] : tv[k]; const float be = k < 4 ? b0[k] : b1[k - 4], bw = k < 4 ? w0[k] : w1[k - 4]; ob[k] = v * be; ow[k] = v * bw; }
                *(LAS u32x4*)(TmB + rr * 72 + cb) = pack8(ob); *(LAS u32x4*)(TmW + rr * 72 + cb) = pack8(ow); }
            lds_barrier();
            if (F.wave < 4) { const int tr = F.wave; bf16_t* UT = (bf16_t*)(F.ws + SC_UT) + ((size_t)d * NUNIT + u) * 128 * 64;
                bf16x8 fa[2], fb[8][2];
#pragma unroll
                for (int ks = 0; ks < 2; ++ks) { fa[ks] = lds_frag(TmB, 72, tr * 16, ks * 32, lane);
#pragma unroll
                    for (int tc = 0; tc < 8; ++tc) fb[tc][ks] = lds_frag(vTl, 72, tc * 16, ks * 32, lane); }
                __builtin_amdgcn_sched_barrier(0);
#pragma unroll
                for (int tc = 0; tc < 8; ++tc) { f32x4 acc = {0.f, 0.f, 0.f, 0.f};
#pragma unroll
                    for (int ks = 0; ks < 2; ++ks) acc = MFMA16(fa[ks], fb[tc][ks], acc);
                    u32x2 o; o.x = pk2(acc[0], acc[1]); o.y = pk2(acc[2], acc[3]);
                    *(u32x2*)(UT + (size_t)(tc * 16 + l15) * 64 + tr * 16 + 4 * quad) = o; }
            } else { const int tcc = F.wave - 4; bf16_t* W = (bf16_t*)(F.ws + SC_W) + ((size_t)d * NUNIT + u) * 64 * 128;
                bf16x8 fb[2], fa[8][2];
#pragma unroll
                for (int ks = 0; ks < 2; ++ks) { fb[ks] = lds_frag(TmW, 72, tcc * 16, ks * 32, lane);
#pragma unroll
                    for (int tn = 0; tn < 8; ++tn) fa[tn][ks] = lds_frag(kTl, 72, tn * 16, ks * 32, lane); }
                __builtin_amdgcn_sched_barrier(0);
#pragma unroll
                for (int tn = 0; tn < 8; ++tn) { f32x4 acc = {0.f, 0.f, 0.f, 0.f};
#pragma unroll
                    for (int ks = 0; ks < 2; ++ks) acc = MFMA16(fa[tn][ks], fb[ks], acc);
                    u32x2 o; o.x = pk2(acc[0], acc[1]); o.y = pk2(acc[2], acc[3]);
                    *(u32x2*)(W + (size_t)(tcc * 16 + l15) * 128 + tn * 16 + 4 * quad) = o; }
            }
            lds_barrier();
        }
        }
        }
#undef REOPQ
    }
#undef DNA_PREFETCH
}

#ifndef DNB_EXTRA
#define DNB_EXTRA 0
#endif
struct DnbSet { u32x4 pw[2], pq[2], pk[2], pa, pu; float pg; };
DI void phase_dn_b(const Frame& F, int jq) {
    LAS bf16_t* St = (LAS bf16_t*)F.lds;
    LAS bf16_t* wl = St + 64 * 136;
    LAS bf16_t* ql = wl + 64 * 136;
    LAS bf16_t* kTl = ql + 64 * 136;
    LAS bf16_t* ail = kTl + 128 * 72;
    LAS bf16_t* uTl = ail + 64 * 72;
    LAS bf16_t* vnT = uTl + 64 * 72;
    LAS bf16_t* vn2T = vnT + 64 * 72;
    LAS float* gl = (LAS float*)(vn2T + 64 * 72);
    const int quad = F.lane >> 4, l15 = F.lane & 15;
    LAS int* claim = (LAS int*)(vn2T + 64 * 72) + 64;
    const unsigned myx = xb_xcc_id() & 7u;
    for (int tries = 0;; ++tries) {
        if (F.tid == 0) { int got = -1;
            for (unsigned k = 0; k < 8u && got < 0; ++k) { const unsigned y = (myx + k) & 7u; unsigned* qh = F.ctl + CW_DNQ + (jq * 16 + (int)y) * 64;
                if (__hip_atomic_load(qh, __ATOMIC_RELAXED, __HIP_MEMORY_SCOPE_AGENT) < 32u) { const unsigned r = __hip_atomic_fetch_add(qh, 1u, __ATOMIC_RELAXED, __HIP_MEMORY_SCOPE_AGENT); if (r < 32u) got = (int)(y * 32u + r); } }
            claim[0] = got; }
        lds_barrier();
        const int u2 = claim[0];
        lds_barrier();
        if (u2 < 0) break;
        const int half = u2 & 1, chain = u2 >> 1;
        const int b = chain >> 5, h = (chain >> 1) & 15, d = chain & 1;
        f32x4 sacc[4];
#pragma unroll
        for (int tc = 0; tc < 4; ++tc) sacc[tc] = (f32x4){0.f, 0.f, 0.f, 0.f};
        for (int i = F.tid; i < 64 * 136 / 2; i += NT) ((LAS unsigned*)St)[i] = 0u;
        DnbSet R0;
#define DNB_CC(step) (d == 0 ? (step) : ((step) < 4 ? 3 - (step) : 71 - (step)))
#define DNB_PREFETCH(R, step) do { const int cc_ = DNB_CC(step); const size_t uu = (size_t)(b * HEADS + h) * NCH + cc_; \
            const bf16_t* Wg = (const bf16_t*)(F.ws + SC_W) + ((size_t)d * NUNIT + uu) * 8192; const bf16_t* Qg = (const bf16_t*)(F.ws + SC_QN) + uu * 8192; \
            const bf16_t* Kg = (const bf16_t*)(F.ws + SC_KT) + uu * 8192; const bf16_t* Ag = (const bf16_t*)(F.ws + SC_AI) + ((size_t)d * NUNIT + uu) * 4096; \
            const bf16_t* Ug = (const bf16_t*)(F.ws + SC_UT) + ((size_t)d * NUNIT + uu) * 8192 + (size_t)half * 64 * 64; \
            _Pragma("unroll") for (int i = 0; i < 2; ++i) { R.pw[i] = *(const u32x4*)(Wg + (size_t)(F.tid + NT * i) * 8); } \
            if (F8QK) { R.pq[0] = *(const u32x4*)((const unsigned char*)(F.ws + SC_QN) + uu * 8192 + (size_t)F.tid * 16); R.pk[0] = *(const u32x4*)((const unsigned char*)(F.ws + SC_KT) + uu * 8192 + (size_t)F.tid * 16); } \
            else { _Pragma("unroll") for (int i = 0; i < 2; ++i) { R.pq[i] = *(const u32x4*)(Qg + (size_t)(F.tid + NT * i) * 8); R.pk[i] = *(const u32x4*)(Kg + (size_t)(F.tid + NT * i) * 8); } } \
            R.pa = *(const u32x4*)(Ag + (size_t)F.tid * 8); R.pu = *(const u32x4*)(Ug + (size_t)F.tid * 8); \
            if (DNB_EXTRA) { const bf16_t* Xg = (const bf16_t*)(F.ws + SC_W) + ((size_t)(1 - d) * NUNIT + ((uu + 1088 + half * 2176) % NUNIT)) * 8192; _Pragma("unroll") for (int i = 0; i < 2; ++i) { const u32x4 dm = *(const u32x4*)(Xg + (size_t)(F.tid + NT * i) * 8); asm volatile("" :: "v"(dm)); } } \
            R.pg = 0.f; if (F.tid < 64) R.pg = ((const float*)(F.ws + SC_G))[((size_t)d * NUNIT + uu) * 64 + F.tid]; } while (0)
#define DNB_STEP(R, step) do { \
            const int cc = DNB_CC(step); const int row0 = chunk_row0(b, cc); \
            _Pragma("unroll") for (int i = 0; i < 2; ++i) { const int item = F.tid + NT * i; \
                *(LAS u32x4*)(wl + (item >> 4) * 136 + (item & 15) * 8) = R.pw[i]; \
                if (!F8QK) { *(LAS u32x4*)(ql + (item >> 4) * 136 + (item & 15) * 8) = R.pq[i]; *(LAS u32x4*)(kTl + (item >> 3) * 72 + (item & 7) * 8) = R.pk[i]; } } \
            if (F8QK) { _Pragma("unroll") for (int hh = 0; hh < 2; ++hh) { const u32x2 q0 = f8x4_to_bf16x4(R.pq[0][hh * 2]), q1 = f8x4_to_bf16x4(R.pq[0][hh * 2 + 1]), k0 = f8x4_to_bf16x4(R.pk[0][hh * 2]), k1 = f8x4_to_bf16x4(R.pk[0][hh * 2 + 1]); \
                    *(LAS u32x4*)(ql + (F.tid >> 3) * 136 + (F.tid & 7) * 16 + hh * 8) = (u32x4){q0.x, q0.y, q1.x, q1.y}; *(LAS u32x4*)(kTl + (F.tid >> 2) * 72 + (F.tid & 3) * 16 + hh * 8) = (u32x4){k0.x, k0.y, k1.x, k1.y}; } } \
            *(LAS u32x4*)(ail + (F.tid >> 3) * 72 + (F.tid & 7) * 8) = R.pa; *(LAS u32x4*)(uTl + (F.tid >> 3) * 72 + (F.tid & 7) * 8) = R.pu; \
            if (F.tid < 64) gl[F.tid] = R.pg; \
            lds_barrier();                                                                \
            if ((step) + 1 < NCH) DNB_PREFETCH(R, (step) + 1); \
            const int trt = F.wave & 3, tc0 = (F.wave >> 2) * 2; const int tk = trt * 16 + 4 * quad; \
              \
            bf16x8 aw[4], bs[2][4]; u32x2 uu2[2]; \
            _Pragma("unroll") for (int ks = 0; ks < 4; ++ks) { aw[ks] = lds_frag(wl, 136, trt * 16, ks * 32, F.lane); bs[0][ks] = lds_frag(St, 136, tc0 * 16, ks * 32, F.lane); bs[1][ks] = lds_frag(St, 136, tc0 * 16 + 16, ks * 32, F.lane); } \
            _Pragma("unroll") for (int q = 0; q < 2; ++q) uu2[q] = *(const LAS u32x2*)(uTl + ((tc0 + q) * 16 + l15) * 72 + tk); \
            const float glast = d == 0 ? gl[63] : gl[0]; \
            const float ksc_ = F8QK ? 1.0f / (float)(1 << F8_SK) : 1.0f, qsc_ = F8QK ? 1.0f / (float)(1 << F8_SQ) : 1.0f;     \
            const float e0 = __expf(glast - gl[tk]) * ksc_, e1 = __expf(glast - gl[tk + 1]) * ksc_, e2 = __expf(glast - gl[tk + 2]) * ksc_, e3 = __expf(glast - gl[tk + 3]) * ksc_; \
            const float eg = __expf(gl[trt * 16 + l15]) * qsc_, gS = __expf(glast); \
            __builtin_amdgcn_sched_barrier(0); \
              \
            {   f32x4 a0 = {0.f, 0.f, 0.f, 0.f}, a1 = {0.f, 0.f, 0.f, 0.f}; \
                _Pragma("unroll") for (int ks = 0; ks < 4; ++ks) { a0 = MFMA16(aw[ks], bs[0][ks], a0); a1 = MFMA16(aw[ks], bs[1][ks], a1); } \
                _Pragma("unroll") for (int q = 0; q < 2; ++q) { const f32x4 acc = q ? a1 : a0; const int dv = (tc0 + q) * 16 + l15; \
                    const float v0 = __uint_as_float(uu2[q].x << 16) - acc[0], v1 = __uint_as_float(uu2[q].x & 0xffff0000u) - acc[1], v2 = __uint_as_float(uu2[q].y << 16) - acc[2], v3 = __uint_as_float(uu2[q].y & 0xffff0000u) - acc[3]; \
                    u32x2 o; o.x = pk2(v0, v1); o.y = pk2(v2, v3); *(LAS u32x2*)(vnT + dv * 72 + tk) = o; \
                    o.x = pk2(v0 * e0, v1 * e1); o.y = pk2(v2 * e2, v3 * e3); *(LAS u32x2*)(vn2T + dv * 72 + tk) = o; } } \
            lds_barrier();                                                                \
              \
            bf16x8 bq[4], ba[2], vn[2][2], ak[2], v2f[4][2]; \
            _Pragma("unroll") for (int ks = 0; ks < 4; ++ks) bq[ks] = lds_frag(ql, 136, trt * 16, ks * 32, F.lane); \
            _Pragma("unroll") for (int ks = 0; ks < 2; ++ks) { ba[ks] = lds_frag(ail, 72, trt * 16, ks * 32, F.lane); vn[0][ks] = lds_frag(vnT, 72, tc0 * 16, ks * 32, F.lane); vn[1][ks] = lds_frag(vnT, 72, tc0 * 16 + 16, ks * 32, F.lane); \
                ak[ks] = lds_frag(kTl, 72, F.wave * 16, ks * 32, F.lane); \
                _Pragma("unroll") for (int tc = 0; tc < 4; ++tc) v2f[tc][ks] = lds_frag(vn2T, 72, tc * 16, ks * 32, F.lane); } \
            __builtin_amdgcn_sched_barrier(0); \
              \
            {   bf16_t* Og = (bf16_t*)(F.ws + SC_O) + ((size_t)d * NR + row0 + trt * 16 + l15) * D + h * HD + half * 64; \
                f32x4 a0 = {0.f, 0.f, 0.f, 0.f}, a1 = {0.f, 0.f, 0.f, 0.f}; \
                _Pragma("unroll") for (int ks = 0; ks < 4; ++ks) { a0 = MFMA16(bs[0][ks], bq[ks], a0); a1 = MFMA16(bs[1][ks], bq[ks], a1); } \
                a0 = a0 * eg; a1 = a1 * eg; \
                _Pragma("unroll") for (int ks = 0; ks < 2; ++ks) { a0 = MFMA16(vn[0][ks], ba[ks], a0); a1 = MFMA16(vn[1][ks], ba[ks], a1); } \
                if (F8O) { unsigned char* Og8 = F.ws + SC_O + ((size_t)d * NR + row0 + trt * 16 + l15) * D + h * HD + half * 64; a0 = a0 * (float)(1 << F8_SO); a1 = a1 * (float)(1 << F8_SO); \
                    *(unsigned*)(Og8 + tc0 * 16 + 4 * quad) = pk4f8(a0[0], a0[1], a0[2], a0[3]); *(unsigned*)(Og8 + tc0 * 16 + 16 + 4 * quad) = pk4f8(a1[0], a1[1], a1[2], a1[3]); } \
                else { u32x2 o; o.x = pk2(a0[0], a0[1]); o.y = pk2(a0[2], a0[3]); *(u32x2*)(Og + tc0 * 16 + 4 * quad) = o; \
                o.x = pk2(a1[0], a1[1]); o.y = pk2(a1[2], a1[3]); *(u32x2*)(Og + tc0 * 16 + 16 + 4 * quad) = o; } } \
              \
            _Pragma("unroll") for (int tc = 0; tc < 4; ++tc) sacc[tc] = sacc[tc] * gS; \
            _Pragma("unroll") for (int ks = 0; ks < 2; ++ks) \
                _Pragma("unroll") for (int tc = 0; tc < 4; ++tc) sacc[tc] = MFMA16(ak[ks], v2f[tc][ks], sacc[tc]); \
            lds_barrier();                                                                \
            _Pragma("unroll") for (int tc = 0; tc < 4; ++tc) { u32x2 o; o.x = pk2(sacc[tc][0], sacc[tc][1]); o.y = pk2(sacc[tc][2], sacc[tc][3]); \
                *(LAS u32x2*)(St + (tc * 16 + l15) * 136 + F.wave * 16 + 4 * quad) = o; } } while (0)
        DNB_PREFETCH(R0, 0);
#pragma unroll 1
        for (int step = 0; step < NCH; ++step) { DNB_STEP(R0, step); }
        lds_barrier();
#undef DNB_CC
#undef DNB_PREFETCH
#undef DNB_STEP
    }
}
using pg8::Unit;
#ifndef WGM_
#define WGM_ 4
#endif
struct PlainSched {
    const char* A; const char* B; size_t a_bstride, b_bstride, a_tile, b_tile; int nM, nN, nbatch, G, c;
    DI bool next(int i, Unit& u) const {
        const int per = nM * nN; const long L = (long)i * G + c; if (L >= (long)per * nbatch) return false;
        const int bt = (int)(L / per); int wgid = (int)(L % per);
        { const int q = per / 8, r = per % 8, xcd = wgid % 8, off = wgid / 8; wgid = (xcd < r ? xcd * (q + 1) : r * (q + 1) + (xcd - r) * q) + off; }
        const int nig = WGM_ * nN, gid = wgid / nig, fm = gid * WGM_, gsz = (nM - fm) < WGM_ ? (nM - fm) : WGM_;
        u.pm = fm + ((wgid % nig) % gsz); u.pn = (wgid % nig) / gsz; u.aux = bt; u.aux2 = 0;
        u.A = A + (size_t)bt * a_bstride + (size_t)u.pm * a_tile; u.B = B + (size_t)bt * b_bstride + (size_t)u.pn * b_tile; return true;
    }
    DI int grow(const Unit&, int) const { return 0; }
};
struct WpSched { const char* Dt; const char* WB; int G, c, c0;
    DI bool next(int i, Unit& u) const {
        if (c < c0) return false;
        const long L = (long)i * (G - c0) + (c - c0); if (L >= 8 * 16) return false;
        const int bt = (int)(L >> 4), w = (int)(L & 15); u.pm = w & 1; u.pn = w >> 1; u.aux = bt; u.aux2 = 0;
        u.A = Dt + (size_t)u.pm * (256 * 512 * 2); u.B = WB + (size_t)(bt >> 2) * ((size_t)D * D * 2) + (size_t)(bt & 3) * (512 * 2) + (size_t)u.pn * ((size_t)256 * D * 2); return true; }
    DI int grow(const Unit&, int) const { return 0; } };
struct MoeSched {
    const LAS int* pre; const char* A; const char* B; size_t b_estride, a_tile, b_tile; const int* list; int nN, G, c; bool gather;
    DI bool next(int i, Unit& u) const {
        const int ntile = pre[16]; const long L = (long)i * G + c; if (L >= (long)ntile * nN) return false;
        const int rt = (int)(L / nN); u.pn = (int)(L % nN); int e = 0;
#pragma unroll
        for (int k = 1; k < NEXP; ++k) e += (rt >= pre[k]) ? 1 : 0;
        u.pm = rt; u.aux = e; u.aux2 = rt - pre[e];
        u.A = gather ? A : A + (size_t)rt * a_tile; u.B = B + (size_t)e * b_estride + (size_t)u.pn * b_tile; return true;
    }
    DI int grow(const Unit& u, int r) const { const int p = u.aux2 * 256 + r; return p < pre[32 + u.aux] ? list[(size_t)u.aux * LIST_CAP + p] : 0; }
};

#define EPI_LOOP_BF16(ADDR_EXPR) EPI_LOOP_BF16Q(ADDR_EXPR, 0)
#define EPI_LOOP_BF16Q(ADDR_EXPR, QQ) \
    _Pragma("unroll") for (int ai = 0; ai < 2; ++ai) _Pragma("unroll") for (int m = 0; m < 4; ++m) { const int r = ai * 128 + wr * 64 + m * 16 + fr; \
        _Pragma("unroll") for (int bj = 0; bj < 2; ++bj) { const int c8 = bj * 128 + wc * 32 + 8 * fq; f32x4 v0 = acc[ai][bj][m][0], v1 = acc[ai][bj][m][1]; if (QQ) { _Pragma("unroll") for (int z_ = 0; z_ < 4; ++z_) { v0[z_] = q8(v0[z_]); v1[z_] = q8(v1[z_]); } } \
            u32x4 w; w.x = pg8::cvt_pk_bf16(v0[0], v0[1]); w.y = pg8::cvt_pk_bf16(v0[2], v0[3]); w.z = pg8::cvt_pk_bf16(v1[0], v1[1]); w.w = pg8::cvt_pk_bf16(v1[2], v1[3]); \
            bf16_t* dst_ = (ADDR_EXPR); if (dst_) *(u32x4*)dst_ = w; } }

#define EPI_LOOP_F8(ADDR_EXPR, SC) \
    _Pragma("unroll") for (int ai = 0; ai < 2; ++ai) _Pragma("unroll") for (int m = 0; m < 4; ++m) { const int r = ai * 128 + wr * 64 + m * 16 + fr; \
        _Pragma("unroll") for (int bj = 0; bj < 2; ++bj) { const int c8 = bj * 128 + wc * 32 + 8 * fq; const f32x4 v0 = acc[ai][bj][m][0] * (SC), v1 = acc[ai][bj][m][1] * (SC); \
            u32x2 w; w.x = pk4f8(v0[0], v0[1], v0[2], v0[3]); w.y = pk4f8(v1[0], v1[1], v1[2], v1[3]); \
            unsigned char* dst_ = (ADDR_EXPR); if (dst_) *(u32x2*)dst_ = w; } }

struct EpiP { static constexpr bool PERM = true; bf16_t* P; float* AB;
    DI void operator()(const f32x4 (&acc)[2][2][4][2], const Unit& u, int wr, int wc, int fr, int fq) const {
        if (u.pn < 32) { EPI_LOOP_BF16(P + (size_t)(u.pm * 256 + r) * 8192 + u.pn * 256 + c8) }
        else {
#pragma unroll
            for (int ai = 0; ai < 2; ++ai)
#pragma unroll
                for (int m = 0; m < 4; ++m) { const int r = ai * 128 + wr * 64 + m * 16 + fr; const int c8 = wc * 32 + 8 * fq;
                    if (c8 < 64) { float* d = AB + (size_t)(u.pm * 256 + r) * 64 + c8; *(f32x4*)d = acc[ai][0][m][0]; *(f32x4*)(d + 4) = acc[ai][0][m][1]; } }
        }
    } };
struct EpiRes { static constexpr bool PERM = true; bf16_t* XS; const float* gate_base;
    DI void operator()(const f32x4 (&acc)[2][2][4][2], const Unit& u, int wr, int wc, int fr, int fq) const {
        const int mr = u.pm < 64 ? (u.pm >> 4) : 4; const float* g = gate_base + (size_t)mr * (NMOD * D) + u.pn * 256;
#pragma unroll
        for (int bj = 0; bj < 2; ++bj) { const int c8 = bj * 128 + wc * 32 + 8 * fq; const f32x4 g0 = *(const f32x4*)(g + c8), g1 = *(const f32x4*)(g + c8 + 4);
#pragma unroll
            for (int ai = 0; ai < 2; ++ai)
#pragma unroll
                for (int m = 0; m < 4; ++m) { const int r = ai * 128 + wr * 64 + m * 16 + fr; bf16_t* row = XS + (size_t)(u.pm * 256 + r) * D + u.pn * 256;
                    const u32x4 xr = *(const u32x4*)(row + c8);
                    f32x4 x0 = {__uint_as_float(xr.x << 16), __uint_as_float(xr.x & 0xffff0000u), __uint_as_float(xr.y << 16), __uint_as_float(xr.y & 0xffff0000u)};
                    f32x4 x1 = {__uint_as_float(xr.z << 16), __uint_as_float(xr.z & 0xffff0000u), __uint_as_float(xr.w << 16), __uint_as_float(xr.w & 0xffff0000u)};
                    x0 += g0 * acc[ai][bj][m][0]; x1 += g1 * acc[ai][bj][m][1];
                    u32x4 w; w.x = pg8::cvt_pk_bf16(x0[0], x0[1]); w.y = pg8::cvt_pk_bf16(x0[2], x0[3]); w.z = pg8::cvt_pk_bf16(x1[0], x1[1]); w.w = pg8::cvt_pk_bf16(x1[2], x1[3]);
                    *(u32x4*)(row + c8) = w;
                    if (m & 1) asm volatile("" ::: "memory"); } }
    } };
struct EpiWp { static constexpr bool PERM = true; bf16_t* WpT;
    DI void operator()(const f32x4 (&acc)[2][2][4][2], const Unit& u, int wr, int wc, int fr, int fq) const {
#if F8FN
        EPI_LOOP_F8((unsigned char*)WpT + (size_t)(u.aux * 512 + u.pm * 256 + r) * D + u.pn * 256 + c8, (float)(1 << F8_SWP)) } };
#else
        EPI_LOOP_BF16Q(WpT + (size_t)(u.aux * 512 + u.pm * 256 + r) * D + u.pn * 256 + c8, 1) } };
#endif
struct EpiYt { static constexpr bool PERM = true; bf16_t* Yt; bf16_t* YtC; bf16_t* YN; bf16_t* YNc;
    DI void operator()(const f32x4 (&acc)[2][2][4][2], const Unit& u, int wr, int wc, int fr, int fq) const {
        const int n0 = u.pm * 256, g = u.pm >> 1; const bool nyq = (u.pm & 1) && wr == 0 && fr == 0;
        if (u.pn < 64) { const int b = u.pn >> 4, half = (u.pn >> 3) & 1, t0 = (u.pn & 7) * 256;
#if F8FN
            EPI_LOOP_F8((unsigned char*)Yt + ((size_t)(b * D + n0 + r) * 4096) + half * 2048 + t0 + c8, (float)(1 << F8_SYT))
            if (nyq) {
#pragma unroll
                for (int bj = 0; bj < 2; ++bj) { const int c8 = bj * 128 + wc * 32 + 8 * fq; const f32x4 v0 = acc[0][bj][0][0] * (float)(1 << F8_SYT), v1 = acc[0][bj][0][1] * (float)(1 << F8_SYT);
                    u32x2 w; w.x = pk4f8(v0[0], v0[1], v0[2], v0[3]); w.y = pk4f8(v1[0], v1[1], v1[2], v1[3]);
                    *(u32x2*)((unsigned char*)YN + (size_t)(b * 4 + g) * 4096 + half * 2048 + t0 + c8) = w; } } }
#else
            EPI_LOOP_BF16Q(Yt + ((size_t)(b * D + n0 + r) * 4096) + half * 2048 + t0 + c8, 1)
            if (nyq) {
#pragma unroll
                for (int bj = 0; bj < 2; ++bj) { const int c8 = bj * 128 + wc * 32 + 8 * fq; const f32x4 v0 = acc[0][bj][0][0], v1 = acc[0][bj][0][1];
                    u32x4 w; w.x = pg8::cvt_pk_bf16(q8(v0[0]), q8(v0[1])); w.y = pg8::cvt_pk_bf16(q8(v0[2]), q8(v0[3])); w.z = pg8::cvt_pk_bf16(q8(v1[0]), q8(v1[1])); w.w = pg8::cvt_pk_bf16(q8(v1[2]), q8(v1[3]));
                    *(u32x4*)(YN + (size_t)(b * 4 + g) * 4096 + half * 2048 + t0 + c8) = w; } } }
#endif
        else { const int b = u.pn - 64;
            EPI_LOOP_BF16Q(YtC + ((size_t)(b * D + n0 + r) * 256) + c8, 0)
            if (nyq) {
#pragma unroll
                for (int bj = 0; bj < 2; ++bj) { const int c8 = bj * 128 + wc * 32 + 8 * fq; const f32x4 v0 = acc[0][bj][0][0], v1 = acc[0][bj][0][1];
                    u32x4 w; w.x = pg8::cvt_pk_bf16(v0[0], v0[1]); w.y = pg8::cvt_pk_bf16(v0[2], v0[3]); w.z = pg8::cvt_pk_bf16(v1[0], v1[1]); w.w = pg8::cvt_pk_bf16(v1[2], v1[3]);
                    *(u32x4*)(YNc + (size_t)(b * 4 + g) * 256 + c8) = w; } } }
    } };
struct EpiMixP { static constexpr bool PERM = true; bf16_t* O; int row0, bshift, bstride, rstride, pmask;
    DI void operator()(const f32x4 (&acc)[2][2][4][2], const Unit& u, int wr, int wc, int fr, int fq) const {
        const bool sine = u.pn & 1;
#pragma unroll
        for (int ai = 0; ai < 2; ++ai)
#pragma unroll
            for (int m = 0; m < 4; ++m) { const int r = ai * 128 + wr * 64 + m * 16 + fr; bf16_t* rowp = O + (size_t)(row0 + (u.aux >> bshift) * bstride + rstride * (u.pm * 256 + r) + (u.aux & pmask)) * D + u.pn * 256;
#pragma unroll
                for (int bj = 0; bj < 2; ++bj) { const int c8 = bj * 128 + wc * 32 + 8 * fq; f32x4 v0 = acc[ai][bj][m][0], v1 = acc[ai][bj][m][1];
#pragma unroll
                    for (int z_ = 0; z_ < 4; ++z_) { v0[z_] = q8(v0[z_]); v1[z_] = q8(v1[z_]); }
#if F8G2F
                    const float s8 = (float)(1 << F8_SY); unsigned char* rp8 = (unsigned char*)O + (size_t)(rowp - O);
                    u32x2 w; w.x = pk4f8(v0[0] * s8, v0[1] * s8, v0[2] * s8, v0[3] * s8); w.y = pk4f8(v1[0] * s8, v1[1] * s8, v1[2] * s8, v1[3] * s8);
                    if (sine && c8 == 0) { rp8[1] = (unsigned char)(w.x >> 8); *(unsigned short*)(rp8 + 2) = (unsigned short)(w.x >> 16); *(unsigned*)(rp8 + 4) = w.y; }
                    else *(u32x2*)(rp8 + c8) = w; } }
#else
                    u32x4 w; w.x = pg8::cvt_pk_bf16(v0[0], v0[1]); w.y = pg8::cvt_pk_bf16(v0[2], v0[3]); w.z = pg8::cvt_pk_bf16(v1[0], v1[1]); w.w = pg8::cvt_pk_bf16(v1[2], v1[3]);
                    if (sine && c8 == 0) { *(bf16_t*)(rowp + 1) = (bf16_t)(w.x >> 16); *(unsigned*)(rowp + 2) = w.y; *(u32x2*)(rowp + 4) = (u32x2){w.z, w.w}; }
                    else *(u32x4*)(rowp + c8) = w; } }
#endif
    } };
struct EpiMixS { static constexpr bool PERM = true; bf16_t* O;
    DI void operator()(const f32x4 (&acc)[2][2][4][2], const Unit& u, int wr, int wc, int fr, int fq) const {
        const bool sine = u.pn & 1; const int b = u.aux >> 1, par = u.aux & 1;
#pragma unroll
        for (int ai = 0; ai < 2; ++ai)
#pragma unroll
            for (int m = 0; m < 4; ++m) { const int r = ai * 128 + wr * 64 + m * 16 + fr; const int k = 2 * (u.pm * 256 + r) + par;
                bf16_t* row1 = O + (size_t)(b * SEQ + k) * D + u.pn * 256; bf16_t* row2 = O + (size_t)(b * SEQ + SEQ - k) * D + u.pn * 256;
#pragma unroll
                for (int bj = 0; bj < 2; ++bj) { const int c8 = bj * 128 + wc * 32 + 8 * fq; f32x4 v0 = acc[ai][bj][m][0], v1 = acc[ai][bj][m][1];
#pragma unroll
                    for (int z_ = 0; z_ < 4; ++z_) { v0[z_] = q8(v0[z_]); v1[z_] = q8(v1[z_]); }
#if F8G2F
                    const float s8 = (float)(1 << F8_SY); unsigned char* r1 = (unsigned char*)O + (size_t)(row1 - O); unsigned char* r2 = (unsigned char*)O + (size_t)(row2 - O);
                    u32x2 w; w.x = pk4f8(v0[0] * s8, v0[1] * s8, v0[2] * s8, v0[3] * s8); w.y = pk4f8(v1[0] * s8, v1[1] * s8, v1[2] * s8, v1[3] * s8);
                    u32x2 wm = w; if (sine) { wm.x ^= 0x80808080u; wm.y ^= 0x80808080u; }
                    if (sine && c8 == 0) { r1[1] = (unsigned char)(w.x >> 8); *(unsigned short*)(r1 + 2) = (unsigned short)(w.x >> 16); *(unsigned*)(r1 + 4) = w.y;
                        if (k != 0) { r2[1] = (unsigned char)(wm.x >> 8); *(unsigned short*)(r2 + 2) = (unsigned short)(wm.x >> 16); *(unsigned*)(r2 + 4) = wm.y; } }
                    else { *(u32x2*)(r1 + c8) = w; if (k != 0) *(u32x2*)(r2 + c8) = wm; } } }
#else
                    u32x4 w; w.x = pg8::cvt_pk_bf16(v0[0], v0[1]); w.y = pg8::cvt_pk_bf16(v0[2], v0[3]); w.z = pg8::cvt_pk_bf16(v1[0], v1[1]); w.w = pg8::cvt_pk_bf16(v1[2], v1[3]);
                    u32x4 wm = w; if (sine) { wm.x ^= 0x80008000u; wm.y ^= 0x80008000u; wm.z ^= 0x80008000u; wm.w ^= 0x80008000u; }
                    if (sine && c8 == 0) { *(bf16_t*)(row1 + 1) = (bf16_t)(w.x >> 16); *(unsigned*)(row1 + 2) = w.y; *(u32x2*)(row1 + 4) = (u32x2){w.z, w.w};
                        if (k != 0) { *(bf16_t*)(row2 + 1) = (bf16_t)(wm.x >> 16); *(unsigned*)(row2 + 2) = wm.y; *(u32x2*)(row2 + 4) = (u32x2){wm.z, wm.w}; } }
                    else { *(u32x4*)(row1 + c8) = w; if (k != 0) *(u32x4*)(row2 + c8) = wm; } } }
#endif
    } };
struct F2Sched { const char* CT; const char* Yt; int G, c;
    DI bool next(int i, Unit& u) const {
        const long L = (long)i * G + c; if (L >= 8 * 32) return false;
        const int bt = (int)(L >> 5), w = (int)(L & 31); u.pm = w & 3; u.pn = w >> 2; u.aux = bt; u.aux2 = 0;
        constexpr size_t EB = F8FN ? 1 : 2;
        u.A = CT + (size_t)((u.pn & 1) * 2 + (bt & 1)) * ((size_t)2048 * 2048 * EB) + (size_t)u.pm * ((size_t)256 * 2048 * EB);
        u.B = Yt + (size_t)(bt >> 1) * ((size_t)D * 4096 * EB) + (size_t)(bt & 1) * (2048 * EB) + (size_t)u.pn * ((size_t)256 * 4096 * EB); return true; }
    DI int grow(const Unit&, int) const { return 0; } };
struct F2cSched { const char* CT2; const char* YtC; int G, c;
    DI bool next(int i, Unit& u) const {
        const long L = (long)i * G + c; if (L >= 32) return false;
        u.pm = 0; u.pn = (int)(L & 7); u.aux = (int)(L >> 3); u.aux2 = 0;
        u.A = CT2 + (size_t)(u.pn & 1) * (256 * 256 * 2); u.B = YtC + (size_t)u.aux * ((size_t)D * 256 * 2) + (size_t)u.pn * (256 * 256 * 2); return true; }
    DI int grow(const Unit&, int) const { return 0; } };
#if F8G2F
#define OUT1(idx, val) ((unsigned char*)O)[idx] = f2f8((val) * (float)(1 << F8_SY))
#else
#define OUT1(idx, val) O[idx] = f2bf(val)
#endif
DI void nyq_fix(const Frame& F, bool with_ctx) {
    LAS float* red = (LAS float*)F.lds;
    const int quad = F.lane >> 4, l15 = F.lane & 15;
    bf16_t* O = (bf16_t*)(F.ws + WS_HB);
#if F8FN
    const unsigned char* CT = F.ws + WS_CT; const unsigned char* YN = F.ws + SC_YN;
    for (int i = F.bid; i < 256; i += F.G) { const int par = i >> 7, m0 = (i & 127) * 16;
        const unsigned char* Ap = CT + (size_t)par * 2048 * 2048 + (size_t)(m0 + l15) * 2048 + quad * 8; const unsigned char* Bp = YN + (size_t)l15 * 4096 + par * 2048 + quad * 8;
        f32x4 acc = {0.f, 0.f, 0.f, 0.f};
#pragma unroll
        for (int ks = 0; ks < 8; ++ks) { const int k0 = (F.wave * 8 + ks) * 32; acc = __builtin_amdgcn_mfma_f32_16x16x32_fp8_fp8(*(const long*)(Ap + k0), *(const long*)(Bp + k0), acc, 0, 0, 0); }
        acc = acc * (1.0f / (float)(1 << (F8_SCT + F8_SYT)));
#else
    const bf16_t* CT = (const bf16_t*)(F.ws + WS_CT); const bf16_t* YN = (const bf16_t*)(F.ws + SC_YN);
    for (int i = F.bid; i < 256; i += F.G) { const int par = i >> 7, m0 = (i & 127) * 16;
        const bf16_t* Ap = CT + (size_t)par * 2048 * 2048 + (size_t)(m0 + l15) * 2048 + quad * 8; const bf16_t* Bp = YN + (size_t)l15 * 4096 + par * 2048 + quad * 8;
        f32x4 acc = {0.f, 0.f, 0.f, 0.f};
#pragma unroll
        for (int ks = 0; ks < 8; ++ks) { const int k0 = (F.wave * 8 + ks) * 32; acc = MFMA16(*(const bf16x8*)(Ap + k0), *(const bf16x8*)(Bp + k0), acc); }
#endif
        *(LAS f32x4*)(red + (F.wave * 64 + F.lane) * 4) = acc;
        __syncthreads();
        if (F.wave == 0) { f32x4 s = {0.f, 0.f, 0.f, 0.f};
#pragma unroll
            for (int w = 0; w < 8; ++w) s += *(const LAS f32x4*)(red + (w * 64 + F.lane) * 4);
            const int b = l15 >> 2, g = l15 & 3;
#pragma unroll
            for (int jj = 0; jj < 4; ++jj) OUT1((size_t)(b * SEQ + 2 * (m0 + 4 * quad + jj) + par) * D + g * 512 + 256, s[jj]); }
        __syncthreads();
    }
#if F8FN
    {   const unsigned char* Yt = F.ws + SC_YT;
        for (int q = F.bid * 8 + F.wave; q < NB * D; q += F.G * 8) { const int b = q >> 11, n = q & 2047, jr = n & 511;
            if (jr == 256) continue;
            float sres = 0.f;
            if (jr < 256) { const unsigned char* yp = Yt + ((size_t)(b * D + n)) * 4096 + F.lane * 32; float sa = 0.f;
#pragma unroll
                for (int i = 0; i < 2; ++i) { const u32x4 w = *(const u32x4*)(yp + i * 16);
#pragma unroll
                    for (int q4 = 0; q4 < 4; ++q4) { const f32x4 f = unpk4f8(w[q4]); sa += (f[0] - f[1]) + (f[2] - f[3]); } }
                sres = wave_sum(sa) * (1.0f / (64.0f * (float)(1 << F8_SYT))); }
            if (F.lane == 0) OUT1((size_t)(b * SEQ + 2048) * D + n, sres); } }
#else
    {   const bf16_t* Yt = (const bf16_t*)(F.ws + SC_YT);
        for (int q = F.bid * 8 + F.wave; q < NB * D; q += F.G * 8) { const int b = q >> 11, n = q & 2047, jr = n & 511;
            if (jr == 256) continue;
            float sres = 0.f;
            if (jr < 256) { const bf16_t* yp = Yt + ((size_t)(b * D + n)) * 4096 + F.lane * 32; float sa = 0.f;
#pragma unroll
                for (int i = 0; i < 4; ++i) { float f[8]; unpack8(*(const u32x4*)(yp + i * 8), f); sa += (f[0] - f[1]) + (f[2] - f[3]) + (f[4] - f[5]) + (f[6] - f[7]); }
                sres = wave_sum(sa) * (1.0f / 64.0f); }
            if (F.lane == 0) OUT1((size_t)(b * SEQ + 2048) * D + n, sres); } }
#endif
    if (with_ctx) { const bf16_t* CT2 = (const bf16_t*)(F.ws + WS_CT2); const bf16_t* YNc = (const bf16_t*)(F.ws + SC_YNC);
        for (int i = F.bid; i < 16; i += F.G) { const int m0 = i * 16;
            const bf16_t* Ap = CT2 + (size_t)(m0 + l15) * 256 + quad * 8; const bf16_t* Bp = YNc + (size_t)l15 * 256 + quad * 8;
            f32x4 acc = {0.f, 0.f, 0.f, 0.f};
            acc = MFMA16(*(const bf16x8*)(Ap + F.wave * 32), *(const bf16x8*)(Bp + F.wave * 32), acc);
            *(LAS f32x4*)(red + (F.wave * 64 + F.lane) * 4) = acc;
            __syncthreads();
            if (F.wave == 0) { f32x4 s = {0.f, 0.f, 0.f, 0.f};
#pragma unroll
                for (int w = 0; w < 8; ++w) s += *(const LAS f32x4*)(red + (w * 64 + F.lane) * 4);
                const int b = l15 >> 2, g = l15 & 3;
#pragma unroll
                for (int jj = 0; jj < 4; ++jj) OUT1((size_t)(NLAT + b * CTXL + m0 + 4 * quad + jj) * D + g * 512 + 256, s[jj]); }
            __syncthreads();
        } }
}
struct EpiAct { static constexpr bool PERM = true; unsigned char* ACT;
    DI void operator()(const f32x4 (&acc)[2][2][4][2], const Unit& u, int wr, int wc, int fr, int fq) const {
#pragma unroll
        for (int ai = 0; ai < 2; ++ai)
#pragma unroll
            for (int m = 0; m < 4; ++m) { const int r = ai * 128 + wr * 64 + m * 16 + fr; const int c8 = wc * 32 + 8 * fq; float o[8];
#pragma unroll
                for (int n = 0; n < 2; ++n)
#pragma unroll
                    for (int k = 0; k < 4; ++k) o[n * 4 + k] = siluf(acc[ai][0][m][n][k]) * acc[ai][1][m][n][k] * (float)(1 << F8_SACT);
                u32x2 w; w.x = pk4f8(o[0], o[1], o[2], o[3]); w.y = pk4f8(o[4], o[5], o[6], o[7]);
                *(u32x2*)(ACT + (size_t)(u.pm * 256 + r) * DFF + u.pn * 128 + c8) = w; }
    } };
struct EpiYe { static constexpr bool PERM = true; bf16_t* YE;
    DI void operator()(const f32x4 (&acc)[2][2][4][2], const Unit& u, int wr, int wc, int fr, int fq) const {
#if F8YE
        unsigned char* Y8 = (unsigned char*)YE; const float s = (float)(1 << F8_SYE);
#pragma unroll
        for (int ai = 0; ai < 2; ++ai)
#pragma unroll
            for (int m = 0; m < 4; ++m) { const int r = ai * 128 + wr * 64 + m * 16 + fr;
#pragma unroll
                for (int bj = 0; bj < 2; ++bj) { const int c8 = bj * 128 + wc * 32 + 8 * fq; const f32x4 v0 = acc[ai][bj][m][0] * s, v1 = acc[ai][bj][m][1] * s;
                    u32x2 w; w.x = pk4f8(v0[0], v0[1], v0[2], v0[3]); w.y = pk4f8(v1[0], v1[1], v1[2], v1[3]);
                    *(u32x2*)(Y8 + (size_t)(u.pm * 256 + r) * D + u.pn * 256 + c8) = w; } }
#else
        EPI_LOOP_BF16(YE + (size_t)(u.pm * 256 + r) * D + u.pn * 256 + c8)
#endif
    } };
#ifndef EN
#define EN 0x1FFFF
#endif
#ifndef REP
#define REP 0
#endif
struct Args { const float* in[22]; float* out; unsigned char* ws; int ph_lo, ph_hi; };
constexpr int LDS_BYTES = 155648;
constexpr int N_PHASES = 34;

__global__ void __launch_bounds__(NT, 2) __attribute__((amdgpu_waves_per_eu(2, 2))) fwd_kernel(Args args) {
    extern __shared__ __attribute__((aligned(16))) unsigned char lds_raw[];
    Frame F;
    F.lds = (LAS unsigned char*)lds_raw; F.tid = threadIdx.x; F.lane = F.tid & 63; F.wave = __builtin_amdgcn_readfirstlane(F.tid >> 6); F.G = gridDim.x; F.bid = blockIdx.x;
    F.in = (intab_t)__builtin_amdgcn_kernarg_segment_ptr();
    F.out = args.out; F.ws = args.ws; F.ctl = (unsigned*)(args.ws + WS_CTL);
    volatile LAS unsigned* xbw = (volatile LAS unsigned*)(F.lds + LDS_BYTES - 16);
    if (F.tid < 4) xbw[F.tid] = 0u;
    __syncthreads();
    const int lo = args.ph_lo, hi = args.ph_hi;
    XcdBarrier bar; bar.bar = F.ctl + CW_BAR; bar.x = 0; bar.st = xbw;
    if (hi - lo > 1) bar = xcd_barrier_post(F.ctl + CW_BAR, xbw);
    int pc = 0;
#define PHASE_BEGIN { const bool run_ = (pc >= lo && pc < hi); if (run_) { { int t_ = threadIdx.x; GAS unsigned char* w_ = (GAS unsigned char*)args.ws; intab_t k_ = (intab_t)__builtin_amdgcn_kernarg_segment_ptr(); asm volatile("" : "+v"(t_), "+s"(w_), "+s"(k_)); F.tid = t_; F.lane = t_ & 63; F.ws = (unsigned char*)w_; F.in = k_; F.ctl = (unsigned*)(w_ + WS_CTL); F.out = (float*)(GAS float*)args.out; }
#define PHASE_END } if (run_ && pc + 1 < hi) xcd_barrier(bar); ++pc; }
    LAS unsigned char* glds = F.lds;

#ifndef XBAR
#define XBAR 0
#endif
    if (XBAR) { for (int q_ = 0; q_ < 36; ++q_) xcd_barrier(bar); }
    PHASE_BEGIN
#if EN & 1
phase_mod(F);
#if REP & 1
__syncthreads(); phase_mod(F);
#endif
#endif
 PHASE_END

#pragma unroll 1
    for (int layer = 0; layer < DEPTH; ++layer) {
        const bool dn = (layer & 1) == 0; const int j = layer >> 1;
        const int nrows = layer < DEPTH - 1 ? NR : NLAT;
        const int nMr = nrows / 256;
        const int nrows2 = layer >= 2 ? NLAT : nrows, nMr2 = nrows2 / 256;
        PHASE_BEGIN
#if EN & 2
phase_cvt(F, layer);
#if REP & 2
__syncthreads(); phase_cvt(F, layer);
#endif
#endif

#if EN & 4
phase_thin_a(F, layer, nrows, !dn);
#if REP & 4
__syncthreads(); phase_thin_a(F, layer, nrows, !dn);
#endif
#endif
 PHASE_END
        if (dn) {
            PHASE_BEGIN {
#if F8G1
                PlainSched S{(const char*)(F.ws + WS_HB), (const char*)(F.ws + WM_IN), 0, 0, (size_t)256 * D, (size_t)256 * D, nMr, DN_INP / 256, 1, F.G, F.bid};
#define G1DN_ARGS false, 127 - F8_SH - F8_SWIN>(glds, F.tid, D / 2, D / 2, D / 2, S, E)
#else
                PlainSched S{(const char*)(F.ws + WS_HB), (const char*)(F.ws + WM_IN), 0, 0, (size_t)256 * D * 2, (size_t)256 * D * 2, nMr, DN_INP / 256, 1, F.G, F.bid};
#define G1DN_ARGS false>(glds, F.tid, D, D, D, S, E)
#endif
                EpiP E{(bf16_t*)(F.ws + SC_P), (float*)(F.ws + SC_AB)};

#if EN & 256
pg8::gemm_phase<EpiP, PlainSched, G1DN_ARGS;
#if REP & 256
__syncthreads(); pg8::gemm_phase<EpiP, PlainSched, G1DN_ARGS;
#endif
#endif
                if (layer == 0) {
                    { int t_ = F.tid; asm volatile("" : "+v"(t_)); F.tid = t_; F.lane = t_ & 63; }
                    const int per_ = nMr * (DN_INP / 256), c0_ = per_ % F.G;
                    WpSched S2{(const char*)(F.ws + WS_DT), (const char*)(F.ws + WS_WB2), F.G, F.bid, c0_};
                    EpiWp E2{(bf16_t*)(F.ws + WS_WP2)};
                    int kw_ = 512; asm volatile("" : "+s"(kw_));
#if EN & 512
                    pg8::gemm_phase<EpiWp, WpSched, false>(glds, F.tid, kw_, kw_, D, S2, E2);
#endif
                }
 } PHASE_END
            PHASE_BEGIN
#if EN & 8
phase_dn_a(F, j);
#if REP & 8
__syncthreads(); phase_dn_a(F, j);
#endif
#endif
 PHASE_END
            PHASE_BEGIN
#if EN & 16
phase_dn_b(F, j);
#if REP & 16
__syncthreads(); phase_dn_b(F, j);
#endif
#endif
 PHASE_END
            PHASE_BEGIN
#if EN & 32
phase_dn_out(F, j, nrows2);
#if REP & 32
__syncthreads(); phase_dn_out(F, j, nrows2);
#endif
#endif
 PHASE_END
        } else {
            PHASE_BEGIN {
#if F8FN
                PlainSched S{(const char*)(F.ws + WS_WP2) + (size_t)j * ((size_t)D * D), (const char*)(F.ws + WS_HB), 0, 0, (size_t)256 * D, (size_t)256 * D, 8, nMr, 1, F.G, F.bid};
#define G1FN_ARGS false, 127 - F8_SWP - F8_SH>(glds, F.tid, D / 2, D / 2, D / 2, S, E)
#define F2_ARGS false, 127 - F8_SCT - F8_SYT>(glds, F.tid, 1024, 1024, 2048, S, E)
#else
                PlainSched S{(const char*)(F.ws + WS_WP2) + (size_t)j * ((size_t)D * D * 2), (const char*)(F.ws + WS_HB), 0, 0, (size_t)256 * D * 2, (size_t)256 * D * 2, 8, nMr, 1, F.G, F.bid};
#define G1FN_ARGS false>(glds, F.tid, D, D, D, S, E)
#define F2_ARGS false>(glds, F.tid, 2048, 2048, 4096, S, E)
#endif
                EpiYt E{(bf16_t*)(F.ws + SC_YT), (bf16_t*)(F.ws + SC_YTC), (bf16_t*)(F.ws + SC_YN), (bf16_t*)(F.ws + SC_YNC)};
#if EN & 1024
                pg8::gemm_phase<EpiYt, PlainSched, G1FN_ARGS;
#if REP & 1024
                __syncthreads(); pg8::gemm_phase<EpiYt, PlainSched, G1FN_ARGS;
#endif
#endif
            } PHASE_END
            PHASE_BEGIN {
                {   F2Sched S{(const char*)(F.ws + WS_CT), (const char*)(F.ws + SC_YT), F.G, F.bid};
                    EpiMixS E{(bf16_t*)(F.ws + WS_HB)};
#if EN & 2048
                    pg8::gemm_phase<EpiMixS, F2Sched, F2_ARGS;
#if REP & 2048
                    __syncthreads(); pg8::gemm_phase<EpiMixS, F2Sched, F2_ARGS;
#endif
#endif
                }
                if (nrows > NLAT) {
                    F2cSched S{(const char*)(F.ws + WS_CT2), (const char*)(F.ws + SC_YTC), F.G, F.bid};
                    EpiMixP E{(bf16_t*)(F.ws + WS_HB), NLAT, 0, CTXL, 1, 0};
#if EN & 4096
                    int kc_ = 256; asm volatile("" : "+s"(kc_));
                    pg8::gemm_phase<EpiMixP, F2cSched, false>(glds, F.tid, kc_, kc_, kc_, S, E);
#endif
                }
#if EN & 2048
                nyq_fix(F, nrows > NLAT);
#endif
            } PHASE_END
        }
        PHASE_BEGIN {
            EpiRes E{(bf16_t*)(F.ws + WS_XS), modp(F, layer, 0, 2)};
#if EN & 8192
            if (F8G2 && (dn || F8G2F)) {
                PlainSched S{(const char*)(F.ws + WS_HB), (const char*)(F.ws + WM_OUT), 0, 0, (size_t)256 * D, (size_t)256 * D, nMr2, 8, 1, F.G, F.bid};
                pg8::gemm_phase<EpiRes, PlainSched, false, 127 - F8_SY - F8_SWOUT>(glds, F.tid, D / 2, D / 2, D / 2, S, E);
            } else {
                PlainSched S{(const char*)(F.ws + WS_HB), (const char*)(F.ws + WM_OUT), 0, 0, (size_t)256 * D * 2, (size_t)256 * D * 2, nMr2, 8, 1, F.G, F.bid};
                pg8::gemm_phase<EpiRes, PlainSched, false>(glds, F.tid, D, D, D, S, E);
            }
#endif
 } PHASE_END
        PHASE_BEGIN
#if EN & 64
phase_thin_b(F, layer, nrows2);
#if REP & 64
__syncthreads(); phase_thin_b(F, layer, nrows2);
#endif
#endif
 PHASE_END
        PHASE_BEGIN {
            moe_prefix_to_lds(F, layer);
            MoeSched S{(const LAS int*)(F.lds + MISC_OFF), (const char*)(F.ws + WS_HB), (const char*)(F.ws + WS_WGU), (size_t)1024 * D, 0, (size_t)256 * D, (const int*)(F.ws + WS_LIST), 4, F.G, F.bid, true};
            EpiAct E{F.ws + WS_ACT};

#if EN & 16384
pg8::gemm_phase<EpiAct, MoeSched, true, 127 - F8_SH - F8_SWGU>(glds, F.tid, D / 2, D / 2, D / 2, S, E);
#if REP & 16384
__syncthreads(); pg8::gemm_phase<EpiAct, MoeSched, true, 127 - F8_SH - F8_SWGU>(glds, F.tid, D / 2, D / 2, D / 2, S, E);
#endif
#endif
 } PHASE_END
        PHASE_BEGIN {
            moe_prefix_to_lds(F, layer);
            MoeSched S{(const LAS int*)(F.lds + MISC_OFF), (const char*)(F.ws + WS_ACT), (const char*)(F.ws + WS_WD), (size_t)D * DFF, (size_t)256 * DFF, (size_t)256 * DFF, (const int*)(F.ws + WS_LIST), 8, F.G, F.bid, false};
            EpiYe E{(bf16_t*)(F.ws + WS_YE)};
            int kd_ = DFF / 2; asm volatile("" : "+s"(kd_));

#if EN & 32768
pg8::gemm_phase<EpiYe, MoeSched, false, 127 - F8_SACT - F8_SWD>(glds, F.tid, kd_, DFF / 2, DFF / 2, S, E);
#if REP & 32768
__syncthreads(); pg8::gemm_phase<EpiYe, MoeSched, false, 127 - F8_SACT - F8_SWD>(glds, F.tid, kd_, DFF / 2, DFF / 2, S, E);
#endif
#endif
 } PHASE_END
    }
    PHASE_BEGIN
#if EN & 128
phase_final(F);
#if REP & 128
__syncthreads(); phase_final(F);
#endif
#endif
 PHASE_END
#undef PHASE_BEGIN
#undef PHASE_END
}

extern "C" void kernel_launch(void* const* d_in, const int* in_sizes, int n_in, void* d_out, int out_size, void* d_ws, size_t ws_size, hipStream_t stream) {
    static int grid = 0;
    if (grid == 0) {
        if (n_in != 22 || out_size != NLAT * D || ws_size < WS_END) { fprintf(stderr, "kernel_launch: unexpected shapes (n_in %d, out %d, ws %zu, need %zu)\n", n_in, out_size, ws_size, (size_t)WS_END); grid = -1; return; }
        int dev = 0, cus = 0, per_cu = 0;
        if (hipGetDevice(&dev) != hipSuccess || hipDeviceGetAttribute(&cus, hipDeviceAttributeMultiprocessorCount, dev) != hipSuccess) { grid = -1; return; }
        if (hipFuncSetAttribute((const void*)fwd_kernel, hipFuncAttributeMaxDynamicSharedMemorySize, LDS_BYTES) != hipSuccess) { fprintf(stderr, "kernel_launch: hipFuncSetAttribute failed\n"); grid = -1; return; }
        if (hipOccupancyMaxActiveBlocksPerMultiprocessor(&per_cu, (const void*)fwd_kernel, NT, LDS_BYTES) != hipSuccess || per_cu < 1) { fprintf(stderr, "kernel_launch: occupancy query says %d\n", per_cu); (void)hipGetLastError(); }
        grid = cus;
    }
    if (grid < 0) return;
    (void)hipMemsetAsync((char*)d_ws + WS_CTL, 0, CTL_BYTES, stream);
    Args a{};
    for (int i = 0; i < 22; ++i) a.in[i] = (const float*)d_in[i];
    a.out = (float*)d_out; a.ws = (unsigned char*)d_ws;
#if N_LAUNCH_MODE == 0
    a.ph_lo = 0; a.ph_hi = N_PHASES;
    hipLaunchKernelGGL(fwd_kernel, dim3(grid), dim3(NT), LDS_BYTES, stream, a);
#else
    for (int p = 0; p < N_PHASES; ++p) { a.ph_lo = p; a.ph_hi = p + 1; hipLaunchKernelGGL(fwd_kernel, dim3(grid), dim3(NT), LDS_BYTES, stream, a); }
#endif
}
```
